# Optimizing an MI355X kernel written in HIP

```python
import math
import jax
import jax.numpy as jnp
from jax import lax
import numpy as np

D_MODEL = 1024
BATCH = 8
SEQ = 2048
DEPTH = 1

N_META = 16
CHUNK = 64
META_PAD = (-N_META) % CHUNK
N_FGROUPS = 4
FGROUP_DIM = 128
F_WIDTH = N_FGROUPS * FGROUP_DIM
N_HEADS = 8
HEAD_DK = 128
HEAD_DV = 128
QK_WIDTH = N_HEADS * HEAD_DK
V_WIDTH = N_HEADS * HEAD_DV
QKV_WIDTH = 2 * QK_WIDTH + V_WIDTH
CONV_K = 5
SPLIT_SIZES = (F_WIDTH, QKV_WIDTH, V_WIDTH, 4 * N_HEADS, D_MODEL, D_MODEL)
IN_WIDTH = sum(SPLIT_SIZES)
N_GROUPS = 8
EXPERTS_PER_GROUP = 8
N_EXPERTS = N_GROUPS * EXPERTS_PER_GROUP
TOP_K = 2
D_EXPERT = 256
EXPERT_BLOCK = 128
NORM_EPS = 1e-6

kernel_name = "fnet_bigdn_hier_moe_hybrid"


def rms_norm(x, gain):
    xf = x.astype(jnp.float32)
    y = xf * lax.rsqrt(jnp.mean(xf * xf, axis=-1, keepdims=True) + NORM_EPS)
    return (y * gain.astype(jnp.float32)).astype(x.dtype)


def l2_normalize(x):
    return x * lax.rsqrt(jnp.sum(x * x, axis=-1, keepdims=True) + NORM_EPS)


def depthwise_conv_centred(x, w):
    k = w.shape[0]
    return lax.conv_general_dilated(
        x, w[:, None, :].astype(x.dtype), window_strides=(1,),
        padding=[((k - 1) // 2, k // 2)],
        dimension_numbers=("NWC", "WIO", "NWC"),
        feature_group_count=x.shape[-1])


def gated_delta_chunked(q, k, v, g, beta):
    b, h, lp, dk = k.shape
    dv = v.shape[-1]
    nc = lp // CHUNK
    q = q.reshape(b, h, nc, CHUNK, dk)
    k = k.reshape(b, h, nc, CHUNK, dk)
    v = v.reshape(b, h, nc, CHUNK, dv)
    beta = beta.reshape(b, h, nc, CHUNK)
    g = jnp.cumsum(g.reshape(b, h, nc, CHUNK), axis=-1)
    lower = jnp.tril(jnp.ones((CHUNK, CHUNK), dtype=bool))
    strict = jnp.tril(jnp.ones((CHUNK, CHUNK), dtype=bool), -1)
    diff = g[..., :, None] - g[..., None, :]
    decay = jnp.where(lower, jnp.exp(jnp.where(lower, diff, 0.0)), 0.0)
    k_beta = k * beta[..., None]
    a_mat = jnp.where(strict, jnp.einsum("bhncd,bhnsd->bhncs", k_beta, k) * decay, 0.0)
    eye = jnp.eye(CHUNK, dtype=a_mat.dtype)
    t_mat = lax.linalg.triangular_solve(
        eye + a_mat, jnp.broadcast_to(eye, a_mat.shape),
        left_side=True, lower=True, unit_diagonal=True)
    u = jnp.einsum("bhncs,bhnsv->bhncv", t_mat, v * beta[..., None])
    w = jnp.einsum("bhncs,bhnsd->bhncd", t_mat, k_beta * jnp.exp(g)[..., None])
    qk = jnp.where(lower, jnp.einsum("bhncd,bhnsd->bhncs", q, k) * decay, 0.0)
    q_dec = q * jnp.exp(g)[..., None]
    k_dec = k * jnp.exp(g[..., -1:] - g)[..., None]
    chunk_decay = jnp.exp(g[..., -1])

    def step(state, inp):
        q_c, k_c, u_c, w_c, qk_c, dec_c = inp
        v_new = u_c - jnp.einsum("bhcd,bhdv->bhcv", w_c, state)
        o_c = (jnp.einsum("bhcd,bhdv->bhcv", q_c, state)
               + jnp.einsum("bhcs,bhsv->bhcv", qk_c, v_new))
        state = state * dec_c[..., None, None] + jnp.einsum("bhcd,bhcv->bhdv", k_c, v_new)
        return state, o_c

    xs = tuple(jnp.moveaxis(t, 2, 0) for t in (q_dec, k_dec, u, w, qk, chunk_decay))
    state0 = jnp.zeros((b, h, dk, dv), jnp.float32)
    _, o = lax.scan(step, state0, xs)
    return jnp.moveaxis(o, 0, 2).reshape(b, h, lp, dv)


def pad_to_chunks(t):
    t = jnp.pad(t, [(0, 0), (META_PAD, 0)] + [(0, 0)] * (t.ndim - 2))
    return jnp.moveaxis(t, 1, 2)


def hybrid_mixer(h, norm_g, w_in, conv_w, a_log_f, dt_bias_f, a_log_b, dt_bias_b,
                 out_norm_g, w_fourier, w_delta, w_out):
    bsz, seq_len, _ = h.shape
    hn = rms_norm(h, norm_g)
    proj = hn @ w_in
    points = np.cumsum(SPLIT_SIZES)[:-1].tolist()
    f_in, qkv, z, ab, gate_f, gate_d = jnp.split(proj, points, axis=-1)

    fg = f_in.reshape(bsz, seq_len, N_FGROUPS, FGROUP_DIM).astype(jnp.float32)
    f_mix = jnp.real(jnp.fft.fft2(fg, axes=(1, 3), norm="ortho")).astype(h.dtype)
    y_f = f_mix.reshape(bsz, seq_len, F_WIDTH) @ w_fourier

    qkv = jax.nn.silu(depthwise_conv_centred(qkv, conv_w))
    q, k, v = jnp.split(qkv, [QK_WIDTH, 2 * QK_WIDTH], axis=-1)
    q = l2_normalize(q.reshape(bsz, seq_len, N_HEADS, HEAD_DK).astype(jnp.float32)) * (HEAD_DK ** -0.5)
    k = l2_normalize(k.reshape(bsz, seq_len, N_HEADS, HEAD_DK).astype(jnp.float32))
    v = v.reshape(bsz, seq_len, N_HEADS, HEAD_DV).astype(jnp.float32)
    a_f, b_f, a_b, b_b = jnp.split(ab.astype(jnp.float32), 4, axis=-1)
    g_f = -jnp.exp(a_log_f.astype(jnp.float32)) * jax.nn.softplus(a_f + dt_bias_f.astype(jnp.float32))
    g_b = -jnp.exp(a_log_b.astype(jnp.float32)) * jax.nn.softplus(a_b + dt_bias_b.astype(jnp.float32))
    beta_f = jax.nn.sigmoid(b_f)
    beta_b = jax.nn.sigmoid(b_b)

    qp, kp, vp = pad_to_chunks(q), pad_to_chunks(k), pad_to_chunks(v)
    o_fwd = gated_delta_chunked(qp, kp, vp, pad_to_chunks(g_f), pad_to_chunks(beta_f))
    flip = lambda t: jnp.flip(t, axis=2)
    o_bwd = flip(gated_delta_chunked(flip(qp), flip(kp), flip(vp),
                                     flip(pad_to_chunks(g_b)), flip(pad_to_chunks(beta_b))))
    o = jnp.moveaxis(o_fwd + o_bwd, 1, 2)[:, META_PAD:]
    zf = z.reshape(bsz, seq_len, N_HEADS, HEAD_DV).astype(jnp.float32)
    o = rms_norm(o, out_norm_g) * jax.nn.silu(zf)
    y_d = o.reshape(bsz, seq_len, V_WIDTH).astype(h.dtype) @ w_delta

    merged = jax.nn.sigmoid(gate_f) * y_f + jax.nn.sigmoid(gate_d) * y_d
    return merged @ w_out


def hierarchical_moe(h, norm_g, w_rg, b_rg, w_re, b_re, w_gate, w_up, w_down):
    bsz, seq_len, d = h.shape
    hn = rms_norm(h, norm_g).reshape(-1, d)
    n_tok = hn.shape[0]
    gl = (hn @ w_rg).astype(jnp.float32) + b_rg.astype(jnp.float32)
    gp = jax.nn.softmax(gl, axis=-1)
    p_group, g_idx = lax.top_k(gp, 1)
    el = (hn @ w_re).astype(jnp.float32) + b_re.astype(jnp.float32)
    el = el.reshape(n_tok, N_GROUPS, EXPERTS_PER_GROUP)
    el_g = jnp.take_along_axis(el, g_idx[:, :, None], axis=1)[:, 0]
    ep = jax.nn.softmax(el_g, axis=-1)
    top_w, top_i = lax.top_k(ep, TOP_K)
    top_w = top_w / jnp.sum(top_w, axis=-1, keepdims=True)
    weights = p_group * top_w
    expert_idx = g_idx * EXPERTS_PER_GROUP + top_i

    n_assign = n_tok * TOP_K
    n_blocks = -(-n_assign // EXPERT_BLOCK) + N_EXPERTS
    n_slots = n_blocks * EXPERT_BLOCK
    flat_e = expert_idx.reshape(-1).astype(jnp.int32)
    flat_tok = jnp.repeat(jnp.arange(n_tok, dtype=jnp.int32), TOP_K)
    flat_w = weights.reshape(-1)
    order = jnp.argsort(flat_e, stable=True)
    e_sorted = flat_e[order]
    counts = jnp.bincount(flat_e, length=N_EXPERTS)
    padded_counts = (counts + EXPERT_BLOCK - 1) // EXPERT_BLOCK * EXPERT_BLOCK
    padded_ends = jnp.cumsum(padded_counts)
    padded_start = padded_ends - padded_counts
    start = jnp.cumsum(counts) - counts
    rank = jnp.arange(n_assign, dtype=jnp.int32) - start[e_sorted]
    dest = padded_start[e_sorted] + rank
    slot_tok = jnp.zeros((n_slots,), jnp.int32).at[dest].set(flat_tok[order])
    slot_w = jnp.zeros((n_slots,), hn.dtype).at[dest].set(flat_w[order].astype(hn.dtype))
    block_start = jnp.arange(n_blocks, dtype=jnp.int32) * EXPERT_BLOCK
    block_expert = jnp.minimum(jnp.searchsorted(padded_ends, block_start, side="right"),
                               N_EXPERTS - 1).astype(jnp.int32)
    xb = hn[slot_tok].reshape(n_blocks, EXPERT_BLOCK, d)

    def expert_block(args):
        x_blk, e = args
        return (jax.nn.silu(x_blk @ w_gate[e]) * (x_blk @ w_up[e])) @ w_down[e]

    yb = lax.map(expert_block, (xb, block_expert)).reshape(n_slots, d)
    out = jnp.zeros((n_tok, d), hn.dtype).at[slot_tok].add(yb * slot_w[:, None])
    return out.reshape(bsz, seq_len, d)


def setup_inputs(seed: int = 0) -> dict:
    key = jax.random.key(seed)
    ks = jax.random.split(key, 24)
    nrm = lambda k, shape, scale: jax.random.normal(k, shape, jnp.float32) * scale
    gain = lambda k, shape: 1.0 + 0.05 * jax.random.normal(k, shape, jnp.float32)

    def a_log(k):
        return jnp.log(jax.random.uniform(k, (DEPTH, N_HEADS), jnp.float32, minval=1.0, maxval=16.0))

    def dt_bias(k):
        dt = jnp.exp(jax.random.uniform(k, (DEPTH, N_HEADS), jnp.float32,
                                        minval=math.log(1e-3), maxval=math.log(1e-1)))
        return dt + jnp.log(-jnp.expm1(-dt))

    return {
        "x": nrm(ks[0], (BATCH, SEQ, D_MODEL), 1.0),
        "meta_tokens": nrm(ks[1], (N_META, D_MODEL), 1.0),
        "norm1_g": gain(ks[2], (DEPTH, D_MODEL)),
        "w_in": nrm(ks[3], (DEPTH, D_MODEL, IN_WIDTH), D_MODEL ** -0.5),
        "conv_w": nrm(ks[4], (DEPTH, CONV_K, QKV_WIDTH), CONV_K ** -0.5),
        "a_log_fwd": a_log(ks[5]),
        "dt_bias_fwd": dt_bias(ks[6]),
        "a_log_bwd": a_log(ks[7]),
        "dt_bias_bwd": dt_bias(ks[8]),
        "out_norm_g": gain(ks[9], (DEPTH, HEAD_DV)),
        "w_fourier": nrm(ks[10], (DEPTH, F_WIDTH, D_MODEL), F_WIDTH ** -0.5),
        "w_delta": nrm(ks[11], (DEPTH, V_WIDTH, D_MODEL), V_WIDTH ** -0.5),
        "w_out": nrm(ks[12], (DEPTH, D_MODEL, D_MODEL), D_MODEL ** -0.5),
        "norm2_g": gain(ks[13], (DEPTH, D_MODEL)),
        "w_router_group": nrm(ks[14], (DEPTH, D_MODEL, N_GROUPS), D_MODEL ** -0.5),
        "b_router_group": nrm(ks[15], (DEPTH, N_GROUPS), 0.01),
        "w_router_expert": nrm(ks[16], (DEPTH, D_MODEL, N_EXPERTS), D_MODEL ** -0.5),
        "b_router_expert": nrm(ks[17], (DEPTH, N_EXPERTS), 0.01),
        "w_gate_e": nrm(ks[18], (DEPTH, N_EXPERTS, D_MODEL, D_EXPERT), D_MODEL ** -0.5),
        "w_up_e": nrm(ks[19], (DEPTH, N_EXPERTS, D_MODEL, D_EXPERT), D_MODEL ** -0.5),
        "w_down_e": nrm(ks[20], (DEPTH, N_EXPERTS, D_EXPERT, D_MODEL), D_EXPERT ** -0.5),
        "final_norm_g": gain(ks[21], (D_MODEL,)),
    }


def reference(x, meta_tokens, norm1_g, w_in, conv_w, a_log_fwd, dt_bias_fwd, a_log_bwd,
              dt_bias_bwd, out_norm_g, w_fourier, w_delta, w_out, norm2_g, w_router_group,
              b_router_group, w_router_expert, b_router_expert, w_gate_e, w_up_e, w_down_e,
              final_norm_g):
    bsz = x.shape[0]
    meta = jnp.broadcast_to(meta_tokens[None].astype(x.dtype), (bsz, N_META, D_MODEL))
    h = jnp.concatenate([meta, x], axis=1)
    for layer in range(DEPTH):
        h = h + hybrid_mixer(h, norm1_g[layer], w_in[layer], conv_w[layer],
                             a_log_fwd[layer], dt_bias_fwd[layer], a_log_bwd[layer],
                             dt_bias_bwd[layer], out_norm_g[layer], w_fourier[layer],
                             w_delta[layer], w_out[layer])
        h = h + hierarchical_moe(h, norm2_g[layer], w_router_group[layer], b_router_group[layer],
                                 w_router_expert[layer], b_router_expert[layer],
                                 w_gate_e[layer], w_up_e[layer], w_down_e[layer])
    return rms_norm(h, final_norm_g)[:, N_META:]
```

```cpp
#include <hip/hip_runtime.h>
#include <cstdio>

#ifndef MK_LAUNCH_PER_PHASE
#define MK_LAUNCH_PER_PHASE 0
#endif

#define DI __device__ __forceinline__
#define LAS __attribute__((address_space(3)))
typedef unsigned short bf16;
typedef short bf16x8 __attribute__((ext_vector_type(8)));
typedef float f32x4 __attribute__((ext_vector_type(4)));
typedef float f32x2 __attribute__((ext_vector_type(2)));
typedef unsigned u32x4 __attribute__((ext_vector_type(4)));
typedef unsigned u32x2 __attribute__((ext_vector_type(2)));

constexpr int NB = 8, SEQ = 2048, LTOK = 2064, DMOD = 1024, NTOK = NB * SEQ, NMETA = 16;
constexpr int NHEAD = 8, HDIM = 128;
constexpr int KP = 4224, KSIN = 2112;
constexpr int INW = 6688;
constexpr float EPS = 1e-6f;
constexpr int NPHASE = 10;

constexpr size_t MiB = 1u << 20;
constexpr size_t WS_CTL = 0, CTL_BYTES = 1 * MiB;
constexpr size_t WS_RSTD1 = 1 * MiB;
constexpr size_t WS_GB = 1 * MiB + 128 * 1024;
constexpr size_t WS_WF = 4 * MiB;
constexpr size_t WS_WD = 5 * MiB;
constexpr size_t WS_WO = 7 * MiB;
constexpr size_t WS_WR = 9 * MiB;
constexpr size_t WS_WAB = 9 * MiB + 512 * 1024;
constexpr size_t WS_RSTD2 = 9 * MiB + 640 * 1024;
constexpr size_t WS_GCUM = 9 * MiB + 768 * 1024;
constexpr size_t WS_ROUTE = 10 * MiB;
constexpr size_t WS_ROWINFO = 10 * MiB + 512 * 1024;
constexpr size_t WS_Z = 11 * MiB;
constexpr size_t WS_FM = 43 * MiB;
constexpr size_t WS_DM = 59 * MiB;
constexpr size_t WS_OF = 59 * MiB;
constexpr size_t WS_HALO = 76 * MiB;
constexpr size_t WS_XT = 90 * MiB;
constexpr size_t WS_OB = 91 * MiB;
constexpr size_t WS_QKVP = 123 * MiB;
constexpr size_t WS_XB = 220 * MiB;
constexpr size_t WS_WTIN = 253 * MiB;
constexpr size_t WS_TQK = 220 * MiB;
constexpr size_t WS_XN = 11 * MiB;
constexpr size_t WS_ROWTOK = 67 * MiB;
constexpr size_t WS_TOKINFO = 71 * MiB;
constexpr int MOE_CAP = 16384;
constexpr size_t WS_HACT = 43 * MiB;
constexpr size_t WS_WGU = 131 * MiB;
constexpr size_t WS_WDN = 195 * MiB;
constexpr size_t WS_YA_A = 72 * MiB, WS_YA_B = 227 * MiB;
constexpr int YA_SPLIT = 112;
constexpr size_t WS_END = 291 * MiB;
constexpr int CW_CNT = 8192;
constexpr int CW_BASE = 1152;
constexpr int CW_NTILES = 1280;
constexpr int CW_TILEE = 1536;
constexpr int CW_DNQ = 1472;
constexpr int CW_READY = 16384;
constexpr int CW_PREPQ = 1408;
constexpr int CW_ZERO = 131072;
constexpr int CW_BAR = 4096;
constexpr int LDS_BARW = 163328;
constexpr int LDS_MOETAB = 155648;

constexpr int LDS_BYTES = 163840;

DI int lane_id() { int l; asm volatile("v_mbcnt_lo_u32_b32 %0, -1, 0\n\tv_mbcnt_hi_u32_b32 %0, -1, %0" : "=v"(l)); return l; }
typedef __bf16 nbf16x2 __attribute__((ext_vector_type(2)));
DI unsigned f2bf(float f) { return (unsigned)__builtin_bit_cast(unsigned short, (__bf16)f); }
DI unsigned pk2(float lo, float hi) { nbf16x2 v = {(__bf16)lo, (__bf16)hi}; return __builtin_bit_cast(unsigned, v); }
DI float bf2f(unsigned b) { return __builtin_bit_cast(float, b << 16); }
DI float bflo(unsigned w) { return __builtin_bit_cast(float, w << 16); }
DI float bfhi(unsigned w) { return __builtin_bit_cast(float, w & 0xffff0000u); }
DI float wave_sum(float v) {
#pragma unroll
    for (int o = 1; o < 64; o <<= 1) v += __shfl_xor(v, o);
    return v;
}
DI void wave_sum8(float (&v)[8]) {
    const int lane = lane_id(); const bool h5 = (lane >> 5) & 1, h4 = (lane >> 4) & 1, h3 = (lane >> 3) & 1;
    float r[4], r2[2], r3;
#pragma unroll
    for (int j = 0; j < 4; ++j) { const float mine = h5 ? v[4 + j] : v[j], oth = h5 ? v[j] : v[4 + j]; r[j] = mine + __shfl_xor(oth, 32); }
#pragma unroll
    for (int j = 0; j < 2; ++j) { const float mine = h4 ? r[2 + j] : r[j], oth = h4 ? r[j] : r[2 + j]; r2[j] = mine + __shfl_xor(oth, 16); }
    { const float mine = h3 ? r2[1] : r2[0], oth = h3 ? r2[0] : r2[1]; r3 = mine + __shfl_xor(oth, 8); }
    r3 += __shfl_xor(r3, 4); r3 += __shfl_xor(r3, 2); r3 += __shfl_xor(r3, 1);
#pragma unroll
    for (int j = 0; j < 8; ++j) v[j] = __builtin_bit_cast(float, __builtin_amdgcn_readlane(__builtin_bit_cast(int, r3), 32 * (j >> 2) + 16 * ((j >> 1) & 1) + 8 * (j & 1)));
}
DI float sigm(float x) { return __builtin_amdgcn_rcpf(1.0f + __expf(-x)); }
DI float siluf(float x) { return x * sigm(x); }
DI float softplusf(float x) { return x > 20.f ? x : log1pf(__expf(x)); }
DI u32x4 pack8(f32x4 a, f32x4 b) { u32x4 w; w.x = pk2(a[0], a[1]); w.y = pk2(a[2], a[3]); w.z = pk2(b[0], b[1]); w.w = pk2(b[2], b[3]); return w; }
DI void unpack8(u32x4 w, f32x4& a, f32x4& b) { a[0] = bflo(w.x); a[1] = bfhi(w.x); a[2] = bflo(w.y); a[3] = bfhi(w.y); b[0] = bflo(w.z); b[1] = bfhi(w.z); b[2] = bflo(w.w); b[3] = bfhi(w.w); }
DI void st16(void* p, u32x4 v) { asm volatile("global_store_dwordx4 %0, %1, off sc1\n\ts_nop 1" :: "v"(p), "v"(v) : "memory"); }
#define LDS_WAIT() asm volatile("s_waitcnt lgkmcnt(0)" ::: "memory")
#define VM_WAIT() asm volatile("s_waitcnt vmcnt(0)" ::: "memory")


#define XB_TMO      128
#define XB_XCNT(j)  (256  + 64 * (j))
#define XB_XSUB(j)  (1280 + 64 * (j))
#define XB_XGEN(j)  (2304 + 64 * (j))
#define XB_TOP      3328
#define XB_TOPGEN   3392
#define XCD_BAR_WORDS 3456
#define XB_SPIN_CAP (1u << 22)
DI unsigned xb_ld(unsigned* p)              { return __hip_atomic_load(p, __ATOMIC_RELAXED, __HIP_MEMORY_SCOPE_AGENT); }
DI unsigned xb_add(unsigned* p, unsigned v) { return __hip_atomic_fetch_add(p, v, __ATOMIC_RELAXED, __HIP_MEMORY_SCOPE_AGENT); }
DI unsigned xb_xcc_id() { return (unsigned)__builtin_amdgcn_s_getreg((3 << 11) | 20) & 0xFu; }
#define XB_SPIN(cond, bar) do { unsigned _sp = 0; while (cond) { __builtin_amdgcn_s_sleep(1); \
    if ((++_sp & 255u) == 0u) { if (xb_ld(&(bar)[XB_TMO])) break; if (_sp > XB_SPIN_CAP) { atomicAdd(&(bar)[XB_TMO], 1u); break; } } } } while (0)
struct XcdBarrier { unsigned* bar; unsigned x; volatile LAS unsigned* st; };
DI XcdBarrier xcd_barrier_post(unsigned* bar, volatile LAS unsigned* st, bool leader) {
    XcdBarrier b; b.bar = bar; b.x = xb_xcc_id(); b.st = st;
    if (leader) (void)xb_add(&bar[XB_XCNT(b.x)], 1u);
    return b;
}
DI void xcd_barrier_complete(unsigned* bar, unsigned x, unsigned& nloc, unsigned& nx) {
    const unsigned G = gridDim.x * gridDim.y * gridDim.z;
    unsigned sum, cnt, mine, sp = 0u;
    for (;;) {
        sum = 0u; cnt = 0u; mine = 0u;
#pragma unroll
        for (unsigned j = 0; j < 16; ++j) { const unsigned c = xb_ld(&bar[XB_XCNT(j)]); sum += c; cnt += (c > 0u) ? 1u : 0u; mine = (j == x) ? c : mine; }
        if (sum == G) break;
        __builtin_amdgcn_s_sleep(1);
        if ((++sp & 255u) == 0u) { if (xb_ld(&bar[XB_TMO])) break; if (sp > XB_SPIN_CAP) { atomicAdd(&bar[XB_TMO], 1u); break; } }
    }
    nloc = mine > 0u ? mine : 1u; nx = cnt > 0u ? cnt : 1u;
}
DI void xcd_barrier(const XcdBarrier& b, bool leader) {
    asm volatile("s_waitcnt vmcnt(0)" ::: "memory");
    __syncthreads();
    if (leader) {
        unsigned* bar = b.bar;
        __builtin_amdgcn_s_waitcnt(0);
        unsigned nloc = b.st[0], nx = b.st[1];
        if (nloc == 0u) { xcd_barrier_complete(bar, b.x, nloc, nx); b.st[0] = nloc; b.st[1] = nx; }
        const unsigned old = xb_add(&bar[XB_XSUB(b.x)], 1u);
        const unsigned gen = old / nloc;
        if (old + 1u == (gen + 1u) * nloc) {
            __builtin_amdgcn_fence(__ATOMIC_RELEASE, "agent");
            asm volatile("s_waitcnt vmcnt(0)" ::: "memory");
            const unsigned og = xb_add(&bar[XB_TOP], 1u);
            const unsigned tg = og / nx;
            if (og + 1u == (tg + 1u) * nx) xb_add(&bar[XB_TOPGEN], 1u);
            else XB_SPIN(xb_ld(&bar[XB_TOPGEN]) == tg, bar);
            __builtin_amdgcn_fence(__ATOMIC_ACQUIRE, "agent");
            xb_add(&bar[XB_XGEN(b.x)], 1u);
            asm volatile("s_waitcnt vmcnt(0)" ::: "memory");
        } else {
            XB_SPIN(xb_ld(&bar[XB_XGEN(b.x)]) == gen, bar);
            __builtin_amdgcn_fence(__ATOMIC_ACQUIRE, "agent");
            asm volatile("s_waitcnt vmcnt(0)" ::: "memory");
        }
    }
    __syncthreads();
}

namespace pg8 {
#define PG8_LAS __attribute__((address_space(3)))
constexpr int BM = 256, BK = 64, HALF = 128, HTB = HALF * BK * 2, STAGE_BYTES = 8 * HTB, NXCD = 8, WGM = 8;
DI int lds_byte(int r, int c) { const int st = (r >> 4) * 2 + (c >> 5), rr = r & 15, cc = c & 31, ob = rr * 64 + cc * 2; return st * 1024 + (ob ^ (((ob >> 9) & 1) << 5)); }
DI void stage_rc(int b, int& R, int& C) { const int st = b / 1024, sb = b % 1024, swz = sb ^ (((sb >> 9) & 1) << 5); R = (st >> 1) * 16 + swz / 64; C = (st & 1) * 32 + (swz % 64) / 2; }
DI int perm32(int rho) { const int n = rho >> 4, i = rho & 15; return 8 * (i >> 2) + 4 * n + (i & 3); }

struct Unit { int pm, pn, aux; };
struct Gemm { const bf16* A; const bf16* Bt; int K; };

struct StaticOrder {
    static constexpr bool WAITS = false;
    int nM, nN, nwg, G, c;
    DI void init(int M, int N, int G_, int c_) { nM = M / BM; nN = N / BM; nwg = nM * nN; G = G_; c = c_; }
    DI bool next(int i, Unit& u) const {
        const long L = (long)i * G + c; if (L >= nwg) return false;
        int wgid = (int)L; { const int q = nwg / NXCD, r = nwg % NXCD, xcd = wgid % NXCD, off = wgid / NXCD; wgid = (xcd < r ? xcd * (q + 1) : r * (q + 1) + (xcd - r) * q) + off; }
        const int nig = WGM * nN, gid = wgid / nig, fm = gid * WGM, gsz = (nM - fm) < WGM ? (nM - fm) : WGM;
        u.pm = fm + ((wgid % nig) % gsz); u.pn = (wgid % nig) / gsz; u.aux = 0; return true;
    }
    DI int arow(const Unit& u) const { return u.pm; }
    DI int brow(const Unit& u) const { return u.pn; }
};
struct DftOrder {
    static constexpr bool WAITS = false;
    int G, c;
    DI bool next(int i, Unit& u) const { const int L = i * G + c; if (L >= 128) return false; u.pm = L >> 1; u.pn = L & 1; u.aux = 0; return true; }
    DI int arow(const Unit& u) const { return u.pm & 7; }
    DI int brow(const Unit& u) const { return (u.pm >> 3) * 2 + u.pn; }
};
struct MoeOrder {
    static constexpr bool WAITS = false;
    int count, nN, G, c; const PG8_LAS int* tab; unsigned* ready;
    DI bool next(int i, Unit& u) const { const int L = i * G + c; if (L >= count) return false; u.pm = L / nN; u.pn = L - u.pm * nN; u.aux = tab[u.pm]; return true; }
    DI int arow(const Unit& u) const { return u.pm; }
    DI int brow(const Unit& u) const { return u.aux * nN + u.pn; }
    DI int rowbase(const Unit& u) const { return tab[256 + u.pm]; }
    DI int nvalid(const Unit& u) const { return tab[512 + u.pm]; }
    DI void done(const Unit& u, int lane) const { asm volatile("s_waitcnt vmcnt(0)" ::: "memory"); if (lane == 0) __hip_atomic_fetch_add(ready + 64 * u.pm, 1u, __ATOMIC_RELAXED, __HIP_MEMORY_SCOPE_AGENT); }
};
struct MoeRangeOrder {
    static constexpr bool WAITS = true;
    int first, count, nN; const PG8_LAS int* tab; unsigned* ready; unsigned need;
    DI bool next(int i, Unit& u) const { if (i >= count) return false; const int L = first + i; u.pm = L / nN; u.pn = L - u.pm * nN; u.aux = tab[u.pm]; return true; }
    DI int arow(const Unit& u) const { return u.pm; }
    DI int brow(const Unit& u) const { return u.aux * nN + u.pn; }
    DI void a_ready(const Unit& u, int wid) const {
        if (wid == 0) { unsigned sp = 0;
            while ((unsigned)__builtin_amdgcn_readfirstlane((int)__hip_atomic_load(ready + 64 * u.pm, __ATOMIC_RELAXED, __HIP_MEMORY_SCOPE_AGENT)) < need) { __builtin_amdgcn_s_sleep(2); if (++sp > (1u << 22)) break; }
            __builtin_amdgcn_fence(__ATOMIC_ACQUIRE, "agent"); asm volatile("s_waitcnt vmcnt(0)" ::: "memory"); }
        asm volatile("" ::: "memory"); __builtin_amdgcn_s_barrier(); asm volatile("" ::: "memory");
    }
};

template <class Epi, class Sched>
DI void gemm_phase(PG8_LAS unsigned char* lds, const Gemm g, const Sched& S, const Epi& E, int wave_id) {
    const int wid = wave_id, lane = lane_id(), tid = wid * 64 + lane, wr = wid >> 2, wc = wid & 3, fr = lane & 15, fq = lane >> 4;
    const int K = g.K, nt = K / BK;
    unsigned voffA[2], voffB[2];
#pragma unroll
    for (int i = 0; i < 2; ++i) { int R, C; stage_rc(tid * 16 + i * 8192, R, C); const int Rb = Epi::PERM ? ((R & ~31) + perm32(R & 31)) : R;
        voffA[i] = (unsigned)(R * K + C) * 2u; voffB[i] = (unsigned)(Rb * K + C) * 2u; }
    const size_t kstep = (size_t)(BK * 2);
    const size_t hstep = (size_t)HALF * K * 2;
    const size_t tstep = 2 * hstep;
    const unsigned ldsw = (unsigned)wid * 1024u;
    const int aoff = lds_byte(wr * 64 + fr, fq * 8), boff = lds_byte(wc * 32 + fr, fq * 8);
#define PG8_SA(b, h) (((b) * 2 + (h)) * HTB)
#define PG8_SB(b, h) ((4 + (b) * 2 + (h)) * HTB)
#define PG8_STAGE(bufoff, gbase, voff) do { _Pragma("unroll") for (int _i = 0; _i < 2; ++_i) \
        __builtin_amdgcn_global_load_lds((const unsigned*)((const char*)(gbase) + (voff)[_i]), (PG8_LAS unsigned*)(lds + (bufoff) + ldsw + _i * 8192), 16, 0, 0); } while (0)
#define PG8_LDA(dst, b, h) do { _Pragma("unroll") for (int m = 0; m < 4; ++m) _Pragma("unroll") for (int k = 0; k < 2; ++k) dst[m][k] = *(const PG8_LAS bf16x8*)(lds + PG8_SA(b, h) + aoff + m * 2048 + k * 1024); } while (0)
#define PG8_LDB(dst, b, h) do { _Pragma("unroll") for (int n = 0; n < 2; ++n) _Pragma("unroll") for (int k = 0; k < 2; ++k) dst[n][k] = *(const PG8_LAS bf16x8*)(lds + PG8_SB(b, h) + boff + n * 2048 + k * 1024); } while (0)
#define PG8_MMA(ai, bj, At, Bt) do { __builtin_amdgcn_s_setprio(1); _Pragma("unroll") for (int m = 0; m < 4; ++m) _Pragma("unroll") for (int n = 0; n < 2; ++n) _Pragma("unroll") for (int k = 0; k < 2; ++k) \
        acc[ai][bj][m][n] = __builtin_amdgcn_mfma_f32_16x16x32_bf16(Bt[n][k], At[m][k], acc[ai][bj][m][n], 0, 0, 0); __builtin_amdgcn_s_setprio(0); } while (0)
#define PG8_WAIT_V(n) asm volatile("s_waitcnt vmcnt(" #n ")" ::: "memory")
#define PG8_WAIT_L(n) asm volatile("s_waitcnt lgkmcnt(" #n ")" ::: "memory")
#define PG8_BAR __builtin_amdgcn_s_barrier()
#define PG8_SCHED __builtin_amdgcn_sched_barrier(0)
    Unit cur, nxt; int ui = 0;
    if (!S.next(0, cur)) return;
    f32x4 acc[2][2][4][2];
#pragma unroll
    for (int a = 0; a < 2; ++a)
#pragma unroll
        for (int b = 0; b < 2; ++b)
#pragma unroll
            for (int m = 0; m < 4; ++m)
#pragma unroll
                for (int n = 0; n < 2; ++n) acc[a][b][m][n] = (f32x4){0.f, 0.f, 0.f, 0.f};
    bf16x8 At[4][2], B0[2][2], B1[2][2];
    const char* cA = (const char*)g.A + (size_t)S.arow(cur) * tstep; const char* cB = (const char*)g.Bt + (size_t)S.brow(cur) * tstep;
    if constexpr (Sched::WAITS) S.a_ready(cur, wid);
    PG8_STAGE(PG8_SB(0, 0), cB, voffB); PG8_STAGE(PG8_SA(0, 0), cA, voffA); PG8_STAGE(PG8_SB(0, 1), cB + hstep, voffB); PG8_STAGE(PG8_SA(0, 1), cA + hstep, voffA);
    if (wr == 1) PG8_BAR;
    PG8_WAIT_V(4); PG8_BAR;
    PG8_STAGE(PG8_SB(1, 0), cB + kstep, voffB); PG8_STAGE(PG8_SA(1, 0), cA + kstep, voffA); PG8_STAGE(PG8_SB(1, 1), cB + hstep + kstep, voffB);
    PG8_WAIT_V(6); PG8_BAR;
    for (;;) {
        const bool has_next = S.next(ui + 1, nxt);
        const char* nA = has_next ? (const char*)g.A + (size_t)S.arow(nxt) * tstep : cA; const char* nB = has_next ? (const char*)g.Bt + (size_t)S.brow(nxt) * tstep : cB;
        for (int t = 0; t < nt; t += 2) {
            const bool last = (t == nt - 2);
            const char* a1 = cA + (size_t)(t + 1) * kstep;
            const char* a2 = last ? nA : cA + (size_t)(t + 2) * kstep; const char* b2 = last ? nB : cB + (size_t)(t + 2) * kstep;
            const char* a3 = a2 + kstep; const char* b3 = b2 + kstep;
            if constexpr (Sched::WAITS) { if (last && has_next) S.a_ready(nxt, wid); }
            PG8_LDB(B0, 0, 0); PG8_SCHED; PG8_LDA(At, 0, 0); PG8_STAGE(PG8_SA(1, 1), a1 + hstep, voffA);
            PG8_WAIT_L(8); PG8_BAR; PG8_WAIT_L(0); PG8_MMA(0, 0, At, B0); PG8_BAR; PG8_SCHED;
            PG8_LDB(B1, 0, 1); PG8_STAGE(PG8_SB(0, 0), b2, voffB);
            PG8_BAR; PG8_WAIT_L(0); PG8_MMA(0, 1, At, B1); PG8_BAR;
            PG8_LDA(At, 0, 1); PG8_STAGE(PG8_SA(0, 0), a2, voffA);
            PG8_BAR; PG8_WAIT_L(0); PG8_MMA(1, 0, At, B0); PG8_BAR; PG8_SCHED;
            PG8_STAGE(PG8_SB(0, 1), b2 + hstep, voffB);
            PG8_WAIT_V(6); PG8_BAR; PG8_MMA(1, 1, At, B1); PG8_BAR;
            PG8_LDB(B0, 1, 0); PG8_SCHED; PG8_LDA(At, 1, 0); PG8_STAGE(PG8_SA(0, 1), a2 + hstep, voffA);
            PG8_WAIT_L(8); PG8_BAR; PG8_WAIT_L(0); PG8_MMA(0, 0, At, B0); PG8_BAR; PG8_SCHED;
            PG8_LDB(B1, 1, 1); PG8_STAGE(PG8_SB(1, 0), b3, voffB);
            PG8_BAR; PG8_WAIT_L(0); PG8_MMA(0, 1, At, B1); PG8_BAR;
            PG8_LDA(At, 1, 1); PG8_STAGE(PG8_SA(1, 0), a3, voffA);
            PG8_BAR; PG8_WAIT_L(0); PG8_MMA(1, 0, At, B0); PG8_BAR; PG8_SCHED;
            PG8_STAGE(PG8_SB(1, 1), b3 + hstep, voffB);
            PG8_WAIT_V(6); PG8_BAR; PG8_MMA(1, 1, At, B1); PG8_BAR;
        }
        { const int ln = lane_id(); E(acc, cur, wr, wc, ln & 15, ln >> 4); }
        if (!has_next) break;
#pragma unroll
        for (int a = 0; a < 2; ++a)
#pragma unroll
            for (int b = 0; b < 2; ++b)
#pragma unroll
                for (int m = 0; m < 4; ++m)
#pragma unroll
                    for (int n = 0; n < 2; ++n) acc[a][b][m][n] = (f32x4){0.f, 0.f, 0.f, 0.f};
        cur = nxt; cA = nA; cB = nB; ++ui;
    }
    PG8_WAIT_V(0);
    if (wr == 0) PG8_BAR;
    PG8_BAR;
#undef PG8_SA
#undef PG8_SB
#undef PG8_STAGE
#undef PG8_LDA
#undef PG8_LDB
#undef PG8_MMA
#undef PG8_WAIT_V
#undef PG8_WAIT_L
#undef PG8_BAR
#undef PG8_SCHED
}

struct Gemm2 { const bf16* A1; int K1; const bf16* A2; int K2; const bf16* Bt; };
template <class Epi, class Sched>
DI void gemm_phase_dual(PG8_LAS unsigned char* lds, const Gemm2 g, const Sched& S, const Epi& E, int wave_id) {
    const int wid = wave_id, lane = lane_id(), tid = wid * 64 + lane, wr = wid >> 2, wc = wid & 3, fr = lane & 15, fq = lane >> 4;
    const int K1 = g.K1, K2 = g.K2, K = K1 + K2, nt = K / BK, k1t = K1 / BK;
    unsigned voffA1[2], voffA2[2], voffB[2];
#pragma unroll
    for (int i = 0; i < 2; ++i) { int R, C; stage_rc(tid * 16 + i * 8192, R, C); const int Rb = Epi::PERM ? ((R & ~31) + perm32(R & 31)) : R;
        voffA1[i] = (unsigned)(R * K1 + C) * 2u; voffA2[i] = (unsigned)(R * K2 + C) * 2u; voffB[i] = (unsigned)(Rb * K + C) * 2u; }
    const size_t kstep = (size_t)(BK * 2);
    const size_t hA1 = (size_t)HALF * K1 * 2, hA2 = (size_t)HALF * K2 * 2, hB = (size_t)HALF * K * 2;
    const unsigned ldsw = (unsigned)wid * 1024u;
    const int aoff = lds_byte(wr * 64 + fr, fq * 8), boff = lds_byte(wc * 32 + fr, fq * 8);
#define PG8_SA(b, h) (((b) * 2 + (h)) * HTB)
#define PG8_SB(b, h) ((4 + (b) * 2 + (h)) * HTB)
#define PG8_STAGE(bufoff, gbase, voff) do { _Pragma("unroll") for (int _i = 0; _i < 2; ++_i) \
        __builtin_amdgcn_global_load_lds((const unsigned*)((const char*)(gbase) + (voff)[_i]), (PG8_LAS unsigned*)(lds + (bufoff) + ldsw + _i * 8192), 16, 0, 0); } while (0)
#define PG8_STAGE_A(bufoff, h, kt, b1, b2) do { const bool _s1 = (kt) < k1t; const char* _p = _s1 ? (b1) + (size_t)(h) * hA1 + (size_t)(kt) * kstep : (b2) + (size_t)(h) * hA2 + (size_t)((kt) - k1t) * kstep; \
        unsigned _v[2]; _v[0] = _s1 ? voffA1[0] : voffA2[0]; _v[1] = _s1 ? voffA1[1] : voffA2[1]; PG8_STAGE(bufoff, _p, _v); } while (0)
#define PG8_LDA(dst, b, h) do { _Pragma("unroll") for (int m = 0; m < 4; ++m) _Pragma("unroll") for (int k = 0; k < 2; ++k) dst[m][k] = *(const PG8_LAS bf16x8*)(lds + PG8_SA(b, h) + aoff + m * 2048 + k * 1024); } while (0)
#define PG8_LDB(dst, b, h) do { _Pragma("unroll") for (int n = 0; n < 2; ++n) _Pragma("unroll") for (int k = 0; k < 2; ++k) dst[n][k] = *(const PG8_LAS bf16x8*)(lds + PG8_SB(b, h) + boff + n * 2048 + k * 1024); } while (0)
#define PG8_MMA(ai, bj, At, Bt) do { __builtin_amdgcn_s_setprio(1); _Pragma("unroll") for (int m = 0; m < 4; ++m) _Pragma("unroll") for (int n = 0; n < 2; ++n) _Pragma("unroll") for (int k = 0; k < 2; ++k) \
        acc[ai][bj][m][n] = __builtin_amdgcn_mfma_f32_16x16x32_bf16(Bt[n][k], At[m][k], acc[ai][bj][m][n], 0, 0, 0); __builtin_amdgcn_s_setprio(0); } while (0)
#define PG8_WAIT_V(n) asm volatile("s_waitcnt vmcnt(" #n ")" ::: "memory")
#define PG8_WAIT_L(n) asm volatile("s_waitcnt lgkmcnt(" #n ")" ::: "memory")
#define PG8_BAR __builtin_amdgcn_s_barrier()
#define PG8_SCHED __builtin_amdgcn_sched_barrier(0)
    Unit cur, nxt; int ui = 0;
    if (!S.next(0, cur)) return;
    f32x4 acc[2][2][4][2];
#pragma unroll
    for (int a = 0; a < 2; ++a)
#pragma unroll
        for (int b = 0; b < 2; ++b)
#pragma unroll
            for (int m = 0; m < 4; ++m)
#pragma unroll
                for (int n = 0; n < 2; ++n) acc[a][b][m][n] = (f32x4){0.f, 0.f, 0.f, 0.f};
    bf16x8 At[4][2], B0[2][2], B1[2][2];
    const char* c1 = (const char*)g.A1 + (size_t)S.arow(cur) * 2 * hA1; const char* c2 = (const char*)g.A2 + (size_t)S.arow(cur) * 2 * hA2; const char* cB = (const char*)g.Bt + (size_t)S.brow(cur) * 2 * hB;
    PG8_STAGE(PG8_SB(0, 0), cB, voffB); PG8_STAGE_A(PG8_SA(0, 0), 0, 0, c1, c2); PG8_STAGE(PG8_SB(0, 1), cB + hB, voffB); PG8_STAGE_A(PG8_SA(0, 1), 1, 0, c1, c2);
    if (wr == 1) PG8_BAR;
    PG8_WAIT_V(4); PG8_BAR;
    PG8_STAGE(PG8_SB(1, 0), cB + kstep, voffB); PG8_STAGE_A(PG8_SA(1, 0), 0, 1, c1, c2); PG8_STAGE(PG8_SB(1, 1), cB + hB + kstep, voffB);
    PG8_WAIT_V(6); PG8_BAR;
    for (;;) {
        const bool has_next = S.next(ui + 1, nxt);
        const char* n1 = has_next ? (const char*)g.A1 + (size_t)S.arow(nxt) * 2 * hA1 : c1; const char* n2 = has_next ? (const char*)g.A2 + (size_t)S.arow(nxt) * 2 * hA2 : c2;
        const char* nB = has_next ? (const char*)g.Bt + (size_t)S.brow(nxt) * 2 * hB : cB;
        for (int t = 0; t < nt; t += 2) {
            const bool last = (t == nt - 2);
            if (t == k1t) { const int ln = lane_id(); E.mid(acc, cur, wr, wc, ln & 15, ln >> 4); }
            const int kt2 = last ? 0 : t + 2, kt3 = kt2 + 1; const char* q1 = last ? n1 : c1; const char* q2 = last ? n2 : c2;
            const char* b2 = last ? nB : cB + (size_t)(t + 2) * kstep; const char* b3 = b2 + kstep;
            PG8_LDB(B0, 0, 0); PG8_SCHED; PG8_LDA(At, 0, 0); PG8_STAGE_A(PG8_SA(1, 1), 1, t + 1, c1, c2);
            PG8_WAIT_L(8); PG8_BAR; PG8_WAIT_L(0); PG8_MMA(0, 0, At, B0); PG8_BAR; PG8_SCHED;
            PG8_LDB(B1, 0, 1); PG8_STAGE(PG8_SB(0, 0), b2, voffB);
            PG8_BAR; PG8_WAIT_L(0); PG8_MMA(0, 1, At, B1); PG8_BAR;
            PG8_LDA(At, 0, 1); PG8_STAGE_A(PG8_SA(0, 0), 0, kt2, q1, q2);
            PG8_BAR; PG8_WAIT_L(0); PG8_MMA(1, 0, At, B0); PG8_BAR; PG8_SCHED;
            PG8_STAGE(PG8_SB(0, 1), b2 + hB, voffB);
            PG8_WAIT_V(6); PG8_BAR; PG8_MMA(1, 1, At, B1); PG8_BAR;
            PG8_LDB(B0, 1, 0); PG8_SCHED; PG8_LDA(At, 1, 0); PG8_STAGE_A(PG8_SA(0, 1), 1, kt2, q1, q2);
            PG8_WAIT_L(8); PG8_BAR; PG8_WAIT_L(0); PG8_MMA(0, 0, At, B0); PG8_BAR; PG8_SCHED;
            PG8_LDB(B1, 1, 1); PG8_STAGE(PG8_SB(1, 0), b3, voffB);
            PG8_BAR; PG8_WAIT_L(0); PG8_MMA(0, 1, At, B1); PG8_BAR;
            PG8_LDA(At, 1, 1); PG8_STAGE_A(PG8_SA(1, 0), 0, kt3, q1, q2);
            PG8_BAR; PG8_WAIT_L(0); PG8_MMA(1, 0, At, B0); PG8_BAR; PG8_SCHED;
            PG8_STAGE(PG8_SB(1, 1), b3 + hB, voffB);
            PG8_WAIT_V(6); PG8_BAR; PG8_MMA(1, 1, At, B1); PG8_BAR;
        }
        { const int ln = lane_id(); E(acc, cur, wr, wc, ln & 15, ln >> 4); }
        if (!has_next) break;
#pragma unroll
        for (int a = 0; a < 2; ++a)
#pragma unroll
            for (int b = 0; b < 2; ++b)
#pragma unroll
                for (int m = 0; m < 4; ++m)
#pragma unroll
                    for (int n = 0; n < 2; ++n) acc[a][b][m][n] = (f32x4){0.f, 0.f, 0.f, 0.f};
        cur = nxt; c1 = n1; c2 = n2; cB = nB; ++ui;
    }
    PG8_WAIT_V(0);
    if (wr == 0) PG8_BAR;
    PG8_BAR;
#undef PG8_SA
#undef PG8_SB
#undef PG8_STAGE
#undef PG8_STAGE_A
#undef PG8_LDA
#undef PG8_LDB
#undef PG8_MMA
#undef PG8_WAIT_V
#undef PG8_WAIT_L
#undef PG8_BAR
#undef PG8_SCHED
}

template <class Epi, class Sched>
DI void gemm_phase_gather(PG8_LAS unsigned char* lds, const Gemm g, const int* rowtok, const Sched& S, const Epi& E, int wave_id) {
    const int wid = wave_id, lane = lane_id(), tid = wid * 64 + lane, wr = wid >> 2, wc = wid & 3, fr = lane & 15, fq = lane >> 4;
    const int K = g.K, nt = K / BK;
    unsigned voffB[2]; int Rr[2], Cc[2];
#pragma unroll
    for (int i = 0; i < 2; ++i) { int R, C; stage_rc(tid * 16 + i * 8192, R, C); const int Rb = Epi::PERM ? ((R & ~31) + perm32(R & 31)) : R;
        Rr[i] = R; Cc[i] = C; voffB[i] = (unsigned)(Rb * K + C) * 2u; }
    const size_t kstep = (size_t)(BK * 2);
    const size_t hstep = (size_t)HALF * K * 2;
    const size_t tstep = 2 * hstep;
    const unsigned ldsw = (unsigned)wid * 1024u;
    const int aoff = lds_byte(wr * 64 + fr, fq * 8), boff = lds_byte(wc * 32 + fr, fq * 8);
#define PG8_SA(b, h) (((b) * 2 + (h)) * HTB)
#define PG8_SB(b, h) ((4 + (b) * 2 + (h)) * HTB)
#define PG8_STAGE(bufoff, gbase, voff) do { _Pragma("unroll") for (int _i = 0; _i < 2; ++_i) \
        __builtin_amdgcn_global_load_lds((const unsigned*)((const char*)(gbase) + (voff)[_i]), (PG8_LAS unsigned*)(lds + (bufoff) + ldsw + _i * 8192), 16, 0, 0); } while (0)
#define PG8_GOFF(u, dst) do { const int _nv = S.nvalid(u), _rb = S.rowbase(u); _Pragma("unroll") for (int _h = 0; _h < 2; ++_h) _Pragma("unroll") for (int _i = 0; _i < 2; ++_i) { \
        const int _R = Rr[_i] + 128 * _h; const int _t = _R < _nv ? rowtok[_rb + _R] : 0; dst[_h][_i] = (unsigned)(_t * K + Cc[_i]) * 2u; } } while (0)
#define PG8_LDA(dst, b, h) do { _Pragma("unroll") for (int m = 0; m < 4; ++m) _Pragma("unroll") for (int k = 0; k < 2; ++k) dst[m][k] = *(const PG8_LAS bf16x8*)(lds + PG8_SA(b, h) + aoff + m * 2048 + k * 1024); } while (0)
#define PG8_LDB(dst, b, h) do { _Pragma("unroll") for (int n = 0; n < 2; ++n) _Pragma("unroll") for (int k = 0; k < 2; ++k) dst[n][k] = *(const PG8_LAS bf16x8*)(lds + PG8_SB(b, h) + boff + n * 2048 + k * 1024); } while (0)
#define PG8_MMA(ai, bj, At, Bt) do { __builtin_amdgcn_s_setprio(1); _Pragma("unroll") for (int m = 0; m < 4; ++m) _Pragma("unroll") for (int n = 0; n < 2; ++n) _Pragma("unroll") for (int k = 0; k < 2; ++k) \
        acc[ai][bj][m][n] = __builtin_amdgcn_mfma_f32_16x16x32_bf16(Bt[n][k], At[m][k], acc[ai][bj][m][n], 0, 0, 0); __builtin_amdgcn_s_setprio(0); } while (0)
#define PG8_WAIT_V(n) asm volatile("s_waitcnt vmcnt(" #n ")" ::: "memory")
#define PG8_WAIT_L(n) asm volatile("s_waitcnt lgkmcnt(" #n ")" ::: "memory")
#define PG8_BAR __builtin_amdgcn_s_barrier()
#define PG8_SCHED __builtin_amdgcn_sched_barrier(0)
    Unit cur, nxt; int ui = 0;
    if (!S.next(0, cur)) return;
    f32x4 acc[2][2][4][2];
#pragma unroll
    for (int a = 0; a < 2; ++a)
#pragma unroll
        for (int b = 0; b < 2; ++b)
#pragma unroll
            for (int m = 0; m < 4; ++m)
#pragma unroll
                for (int n = 0; n < 2; ++n) acc[a][b][m][n] = (f32x4){0.f, 0.f, 0.f, 0.f};
    bf16x8 At[4][2], B0[2][2], B1[2][2];
    unsigned gA[2][2], gN[2][2];
    PG8_GOFF(cur, gA);
    const char* Ab = (const char*)g.A; const char* cB = (const char*)g.Bt + (size_t)S.brow(cur) * tstep;
    PG8_STAGE(PG8_SB(0, 0), cB, voffB); PG8_STAGE(PG8_SA(0, 0), Ab, gA[0]); PG8_STAGE(PG8_SB(0, 1), cB + hstep, voffB); PG8_STAGE(PG8_SA(0, 1), Ab, gA[1]);
    if (wr == 1) PG8_BAR;
    PG8_WAIT_V(4); PG8_BAR;
    PG8_STAGE(PG8_SB(1, 0), cB + kstep, voffB); PG8_STAGE(PG8_SA(1, 0), Ab + kstep, gA[0]); PG8_STAGE(PG8_SB(1, 1), cB + hstep + kstep, voffB);
    PG8_WAIT_V(6); PG8_BAR;
    for (;;) {
        const bool has_next = S.next(ui + 1, nxt);
        if (has_next) PG8_GOFF(nxt, gN); else {
#pragma unroll
            for (int h = 0; h < 2; ++h)
#pragma unroll
                for (int i = 0; i < 2; ++i) gN[h][i] = gA[h][i]; }
        const char* nB = has_next ? (const char*)g.Bt + (size_t)S.brow(nxt) * tstep : cB;
        for (int t = 0; t < nt; t += 2) {
            const bool last = (t == nt - 2);
            const char* a1 = Ab + (size_t)(t + 1) * kstep;
            const char* a2 = last ? Ab : Ab + (size_t)(t + 2) * kstep; const char* b2 = last ? nB : cB + (size_t)(t + 2) * kstep;
            const char* a3 = a2 + kstep; const char* b3 = b2 + kstep;
            unsigned g2[2][2];
#pragma unroll
            for (int h = 0; h < 2; ++h)
#pragma unroll
                for (int i = 0; i < 2; ++i) g2[h][i] = last ? gN[h][i] : gA[h][i];
            PG8_LDB(B0, 0, 0); PG8_SCHED; PG8_LDA(At, 0, 0); PG8_STAGE(PG8_SA(1, 1), a1, gA[1]);
            PG8_WAIT_L(8); PG8_BAR; PG8_WAIT_L(0); PG8_MMA(0, 0, At, B0); PG8_BAR; PG8_SCHED;
            PG8_LDB(B1, 0, 1); PG8_STAGE(PG8_SB(0, 0), b2, voffB);
            PG8_BAR; PG8_WAIT_L(0); PG8_MMA(0, 1, At, B1); PG8_BAR;
            PG8_LDA(At, 0, 1); PG8_STAGE(PG8_SA(0, 0), a2, g2[0]);
            PG8_BAR; PG8_WAIT_L(0); PG8_MMA(1, 0, At, B0); PG8_BAR; PG8_SCHED;
            PG8_STAGE(PG8_SB(0, 1), b2 + hstep, voffB);
            PG8_WAIT_V(6); PG8_BAR; PG8_MMA(1, 1, At, B1); PG8_BAR;
            PG8_LDB(B0, 1, 0); PG8_SCHED; PG8_LDA(At, 1, 0); PG8_STAGE(PG8_SA(0, 1), a2, g2[1]);
            PG8_WAIT_L(8); PG8_BAR; PG8_WAIT_L(0); PG8_MMA(0, 0, At, B0); PG8_BAR; PG8_SCHED;
            PG8_LDB(B1, 1, 1); PG8_STAGE(PG8_SB(1, 0), b3, voffB);
            PG8_BAR; PG8_WAIT_L(0); PG8_MMA(0, 1, At, B1); PG8_BAR;
            PG8_LDA(At, 1, 1); PG8_STAGE(PG8_SA(1, 0), a3, g2[0]);
            PG8_BAR; PG8_WAIT_L(0); PG8_MMA(1, 0, At, B0); PG8_BAR; PG8_SCHED;
            PG8_STAGE(PG8_SB(1, 1), b3 + hstep, voffB);
            PG8_WAIT_V(6); PG8_BAR; PG8_MMA(1, 1, At, B1); PG8_BAR;
        }
        { const int ln = lane_id(); E(acc, cur, wr, wc, ln & 15, ln >> 4); S.done(cur, ln); }
        if (!has_next) break;
#pragma unroll
        for (int a = 0; a < 2; ++a)
#pragma unroll
            for (int b = 0; b < 2; ++b)
#pragma unroll
                for (int m = 0; m < 4; ++m)
#pragma unroll
                    for (int n = 0; n < 2; ++n) acc[a][b][m][n] = (f32x4){0.f, 0.f, 0.f, 0.f};
#pragma unroll
        for (int h = 0; h < 2; ++h)
#pragma unroll
            for (int i = 0; i < 2; ++i) gA[h][i] = gN[h][i];
        cur = nxt; cB = nB; ++ui;
    }
    PG8_WAIT_V(0);
    if (wr == 0) PG8_BAR;
    PG8_BAR;
#undef PG8_SA
#undef PG8_SB
#undef PG8_STAGE
#undef PG8_GOFF
#undef PG8_LDA
#undef PG8_LDB
#undef PG8_MMA
#undef PG8_WAIT_V
#undef PG8_WAIT_L
#undef PG8_BAR
#undef PG8_SCHED
}
}
using pg8::Unit;
typedef f32x4 AccT[2][2][4][2];

struct EpiXT {
    static constexpr bool PERM = true;
    bf16* XT; const float* rstd;
    DI void operator()(const AccT& acc, const Unit& u, int wr, int wc, int fr, int fq) const {
#pragma unroll
        for (int bj = 0; bj < 2; ++bj) {
            const int t0 = u.pn * 256 + bj * 128 + wc * 32 + 8 * fq, b = t0 >> 11, l0 = 16 + (t0 & 2047);

#pragma unroll
            for (int ai = 0; ai < 2; ++ai)
#pragma unroll
                for (int m = 0; m < 4; ++m) {
                    const int np = u.pm * 256 + ai * 128 + wr * 64 + m * 16 + fr;
                    bf16* dst = XT + ((size_t)(b * 512 + (np & 511)) * KP + (np >= 512 ? KSIN : 0) + l0);
                    *(u32x4*)dst = pack8(acc[ai][bj][m][0], acc[ai][bj][m][1]);
                }
        }
    }
};
struct EpiIn {
    static constexpr bool PERM = true;
    bf16 *QKVP, *Z, *GF, *GD; const float* rstd; bf16* HALO;
    DI void operator()(const AccT& acc, const Unit& u, int wr, int wc, int fr, int fq) const {
        const int seg = u.pn < 12 ? 0 : (u.pn < 16 ? 1 : (u.pn < 20 ? 2 : 3));
#pragma unroll
        for (int ai = 0; ai < 2; ++ai)
#pragma unroll
            for (int m = 0; m < 4; ++m) {
                const int t = u.pm * 256 + ai * 128 + wr * 64 + m * 16 + fr;
#pragma unroll
                for (int bj = 0; bj < 2; ++bj) {
                    const int n = u.pn * 256 + bj * 128 + wc * 32 + 8 * fq;
                    f32x4 v0 = acc[ai][bj][m][0], v1 = acc[ai][bj][m][1]; bf16* dst;
                    if (seg == 0) { dst = QKVP + ((size_t)((t >> 11) * LTOK + 16 + (t & 2047)) * 3072 + n);
                        const int sq = t & 2047, ii = sq & 63; int hc = -1, hr = 0;
                        if (ii >= 62) { hc = (sq >> 6) + 1; hr = ii - 62; } else if (ii <= 1) { hc = sq >> 6; hr = 2 + ii; }
                        if (hc >= 0 && hc < 32) *(u32x4*)(HALO + ((size_t)(((t >> 11) * 32 + hc) * 4 + hr) * 3072 + n)) = pack8(v0, v1); }
                    else if (seg == 1) { dst = Z + (size_t)t * 1024 + (n - 3072); }
                    else {
                        unsigned char* gdst = (unsigned char*)(seg == 2 ? GF : GD) + ((size_t)((((((u.pm * 4 + (u.pn & 3)) * 2 + ai) * 4 + m) * 2 + bj) * 8 + wr * 4 + wc) * 64 + fq * 16 + fr)) * 8;
                        unsigned lo = 0u, hi = 0u;
#pragma unroll
                        for (int j = 0; j < 4; ++j) { lo |= (unsigned)(sigm(v0[j]) * 255.0f + 0.5f) << (8 * j); hi |= (unsigned)(sigm(v1[j]) * 255.0f + 0.5f) << (8 * j); }
                        u32x2 w8; w8.x = lo; w8.y = hi; *(u32x2*)gdst = w8; continue; }
                    *(u32x4*)dst = pack8(v0, v1);
                }
            }
    }
};
struct EpiPlain {
    static constexpr bool PERM = true;
    bf16* O; int ldc;
    DI void operator()(const AccT& acc, const Unit& u, int wr, int wc, int fr, int fq) const {
#pragma unroll
        for (int ai = 0; ai < 2; ++ai)
#pragma unroll
            for (int m = 0; m < 4; ++m) {
                const int r = u.pm * 256 + ai * 128 + wr * 64 + m * 16 + fr;
#pragma unroll
                for (int bj = 0; bj < 2; ++bj) { const int c = u.pn * 256 + bj * 128 + wc * 32 + 8 * fq;
                    *(u32x4*)(O + (size_t)r * ldc + c) = pack8(acc[ai][bj][m][0], acc[ai][bj][m][1]); }
            }
    }
};
template <bool ADD> struct EpiMerge {
    static constexpr bool PERM = true;
    bf16* MG; const bf16* GT;
    DI void operator()(const AccT& acc, const Unit& u, int wr, int wc, int fr, int fq) const {
#pragma unroll
        for (int ai = 0; ai < 2; ++ai)
#pragma unroll
            for (int m = 0; m < 4; ++m) {
                const int r = u.pm * 256 + ai * 128 + wr * 64 + m * 16 + fr;
#pragma unroll
                for (int bj = 0; bj < 2; ++bj) { const int c = u.pn * 256 + bj * 128 + wc * 32 + 8 * fq; const size_t o = (size_t)r * 1024 + c;
                    const size_t og = ((size_t)((((((u.pm * 4 + u.pn) * 2 + ai) * 4 + m) * 2 + bj) * 8 + wr * 4 + wc) * 64 + fq * 16 + fr)) * 8;
                    f32x4 g0, g1; { const u32x2 w8 = *(const u32x2*)((const unsigned char*)GT + og);
#pragma unroll
                        for (int j = 0; j < 4; ++j) { g0[j] = (float)((w8.x >> (8 * j)) & 255u) * (1.0f / 255.0f); g1[j] = (float)((w8.y >> (8 * j)) & 255u) * (1.0f / 255.0f); } }
                    f32x4 v0 = acc[ai][bj][m][0] * g0, v1 = acc[ai][bj][m][1] * g1;
                    if (ADD) { f32x4 p0, p1; unpack8(*(const u32x4*)(MG + o), p0, p1); v0 += p0; v1 += p1; }
                    *(u32x4*)(MG + o) = pack8(v0, v1); }
            }
    }
};
struct EpiMerge2 {
    static constexpr bool PERM = true;
    bf16* MG; const unsigned char* GF8; const unsigned char* GD8;
    DI void mid(AccT& acc, const Unit& u, int wr, int wc, int fr, int fq) const {
#pragma unroll
        for (int ai = 0; ai < 2; ++ai)
#pragma unroll
            for (int m = 0; m < 4; ++m)
#pragma unroll
                for (int bj = 0; bj < 2; ++bj) { const size_t og = ((size_t)((((((u.pm * 4 + u.pn) * 2 + ai) * 4 + m) * 2 + bj) * 8 + wr * 4 + wc) * 64 + fq * 16 + fr)) * 8;
                    const u32x2 f8 = *(const u32x2*)(GF8 + og), d8 = *(const u32x2*)(GD8 + og);
#pragma unroll
                    for (int j = 0; j < 4; ++j) { acc[ai][bj][m][0][j] *= (float)((f8.x >> (8 * j)) & 255u) * __builtin_amdgcn_rcpf(fmaxf((float)((d8.x >> (8 * j)) & 255u), 0.5f));
                                                  acc[ai][bj][m][1][j] *= (float)((f8.y >> (8 * j)) & 255u) * __builtin_amdgcn_rcpf(fmaxf((float)((d8.y >> (8 * j)) & 255u), 0.5f)); } }
    }
    DI void operator()(const AccT& acc, const Unit& u, int wr, int wc, int fr, int fq) const {
#pragma unroll
        for (int ai = 0; ai < 2; ++ai)
#pragma unroll
            for (int m = 0; m < 4; ++m) {
                const int r = u.pm * 256 + ai * 128 + wr * 64 + m * 16 + fr;
#pragma unroll
                for (int bj = 0; bj < 2; ++bj) { const int c = u.pn * 256 + bj * 128 + wc * 32 + 8 * fq; const size_t o = (size_t)r * 1024 + c;
                    const size_t og = ((size_t)((((((u.pm * 4 + u.pn) * 2 + ai) * 4 + m) * 2 + bj) * 8 + wr * 4 + wc) * 64 + fq * 16 + fr)) * 8;
                    const u32x2 d8 = *(const u32x2*)(GD8 + og); f32x4 v0, v1;
#pragma unroll
                    for (int j = 0; j < 4; ++j) { v0[j] = acc[ai][bj][m][0][j] * (fmaxf((float)((d8.x >> (8 * j)) & 255u), 0.5f) * (1.0f / 255.0f));
                                                  v1[j] = acc[ai][bj][m][1][j] * (fmaxf((float)((d8.y >> (8 * j)) & 255u), 0.5f) * (1.0f / 255.0f)); }
                    *(u32x4*)(MG + o) = pack8(v0, v1); }
            }
    }
};
struct EpiOut {
    static constexpr bool PERM = false;
    const float* X; float* H2;
    DI void operator()(const AccT& acc, const Unit& u, int wr, int wc, int fr, int fq) const {
#pragma unroll
        for (int ai = 0; ai < 2; ++ai)
#pragma unroll
            for (int m = 0; m < 4; ++m) {
                const int r = u.pm * 256 + ai * 128 + wr * 64 + m * 16 + fr;
#pragma unroll
                for (int bj = 0; bj < 2; ++bj)
#pragma unroll
                    for (int n = 0; n < 2; ++n) { const size_t o = (size_t)r * 1024 + u.pn * 256 + bj * 128 + wc * 32 + 16 * n + 4 * fq;
                        *(f32x4*)(H2 + o) = *(const f32x4*)(X + o) + acc[ai][bj][m][n]; }
            }
    }
};
struct EpiGU {
    static constexpr bool PERM = true;
    bf16* H;
    DI void operator()(const AccT& acc, const Unit& u, int wr, int wc, int fr, int fq) const {
#pragma unroll
        for (int ai = 0; ai < 2; ++ai)
#pragma unroll
            for (int m = 0; m < 4; ++m) {
                const int r = u.pm * 256 + ai * 128 + wr * 64 + m * 16 + fr;
                f32x4 v0, v1;
#pragma unroll
                for (int j = 0; j < 4; ++j) { v0[j] = siluf(acc[ai][0][m][0][j]) * acc[ai][1][m][0][j]; v1[j] = siluf(acc[ai][0][m][1][j]) * acc[ai][1][m][1][j]; }
                st16(H + (size_t)r * 256 + u.pn * 128 + wc * 32 + 8 * fq, pack8(v0, v1));
            }
    }
};
struct EpiDN {
    static constexpr bool PERM = true;
    unsigned char* ws; const LAS int* tab;
    DI void operator()(const AccT& acc, const Unit& u, int wr, int wc, int fr, int fq) const {
        bf16* tile = (bf16*)(ws + (u.pm < YA_SPLIT ? WS_YA_A + (size_t)u.pm * 524288 : WS_YA_B + (size_t)(u.pm - YA_SPLIT) * 524288));
        const int nv = tab[512 + u.pm];
#pragma unroll
        for (int ai = 0; ai < 2; ++ai)
#pragma unroll
            for (int m = 0; m < 4; ++m) {
                const int r = ai * 128 + wr * 64 + m * 16 + fr;
                if (r >= nv) continue;
#pragma unroll
                for (int bj = 0; bj < 2; ++bj) { const int c = u.pn * 256 + bj * 128 + wc * 32 + 8 * fq;
                    *(u32x4*)(tile + (size_t)r * 1024 + c) = pack8(acc[ai][bj][m][0], acc[ai][bj][m][1]); }
            }
    }
};

struct Args { const float* in[22]; float* out; unsigned char* ws; int ph_lo, ph_hi; };
struct Ctx {
    float* out; unsigned char* ws; unsigned char* lds; unsigned* ctl;
    int tid, lane, wave, G, bid, vcu, gw, ngw; bool dry;
};
DI const float* INP(int i) { return ((const float* const __attribute__((address_space(4)))*)__builtin_amdgcn_kernarg_segment_ptr())[i]; }

DI void tr_item(const float* W, int ldw, int k0, int c0, bf16* WT, int ldt, int drow0, const float* sc, int scmask, float* scr, int lane, bool dry = false) {
#pragma unroll 8
    for (int i = 0; i < 32; ++i) { const int kk = 2 * i + (lane >> 5); float v = W[(size_t)(k0 + kk) * ldw + c0 + (lane & 31)]; if (sc) v *= sc[(k0 + kk) & scmask]; scr[kk * 33 + (lane & 31)] = v; }
    LDS_WAIT();
    const int c = lane & 7;
#pragma unroll
    for (int j = 0; j < 4; ++j) { const int n = (lane >> 3) + 8 * j; const float* s = scr + (8 * c) * 33 + n;
        u32x4 o; o.x = pk2(s[0 * 33], s[1 * 33]); o.y = pk2(s[2 * 33], s[3 * 33]); o.z = pk2(s[4 * 33], s[5 * 33]); o.w = pk2(s[6 * 33], s[7 * 33]);
        if (!dry) *(u32x4*)(WT + (size_t)(drow0 + n) * ldt + k0 + 8 * c) = o; }
    LDS_WAIT();
}

DI void tr_item64(const float* W, int ldw, int k0, int c0, bf16* WT, int ldt, int drow_lo, int drow_hi, const float* sc, int scmask, float* scr, int lane, bool dry = false) {
    f32x4 v[16];
#pragma unroll
    for (int i = 0; i < 16; ++i) v[i] = *(const f32x4*)(W + (size_t)(k0 + 4 * i + (lane >> 4)) * ldw + c0 + 4 * (lane & 15));
#pragma unroll
    for (int i = 0; i < 16; ++i) { const int kk = 4 * i + (lane >> 4); f32x4 x = v[i]; if (sc) x *= sc[(k0 + kk) & scmask]; *(f32x4*)(scr + kk * 68 + 4 * (lane & 15)) = x; }
    LDS_WAIT();
    const int c = lane & 7;
#pragma unroll
    for (int j = 0; j < 8; ++j) { const int n = (lane >> 3) + 8 * j; const float* s0 = scr + (8 * c) * 68 + n;
        u32x4 o; o.x = pk2(s0[0 * 68], s0[1 * 68]); o.y = pk2(s0[2 * 68], s0[3 * 68]); o.z = pk2(s0[4 * 68], s0[5 * 68]); o.w = pk2(s0[6 * 68], s0[7 * 68]);
        const int dr = n < 32 ? drow_lo + n : drow_hi + (n - 32);
        if (!dry) *(u32x4*)(WT + (size_t)dr * ldt + k0 + 8 * c) = o; }
    LDS_WAIT();
}

DI void phase_prep(Ctx& F) {
    const float* x = INP(0); const float* meta = INP(1); const float* g1 = INP(2); const float* w_in = INP(3);
    bf16* XB = (bf16*)(F.ws + WS_XB); float* RSTD1 = (float*)(F.ws + WS_RSTD1); bf16* WTIN = (bf16*)(F.ws + WS_WTIN);
    for (int m0 = F.gw; m0 < NTOK + NMETA; m0 += 2 * F.ngw) {
        f32x4 v[2][4];
#pragma unroll
        for (int u = 0; u < 2; ++u) { const int m = m0 + u * F.ngw < NTOK + NMETA ? m0 + u * F.ngw : m0;
            const float* src = m < NTOK ? x + (size_t)m * 1024 : meta + (size_t)(m - NTOK) * 1024;
#pragma unroll
            for (int j = 0; j < 4; ++j) v[u][j] = ((const f32x4*)src)[F.lane + 64 * j]; }
#pragma unroll
        for (int u = 0; u < 2; ++u) { const int m = m0 + u * F.ngw; float s = 0.f;
#pragma unroll
            for (int j = 0; j < 4; ++j) s += (v[u][j][0] * v[u][j][0] + v[u][j][1] * v[u][j][1]) + (v[u][j][2] * v[u][j][2] + v[u][j][3] * v[u][j][3]);
            s = wave_sum(s);
            if (m < NTOK + NMETA) {
                const float rs = __builtin_amdgcn_rsqf(s * (1.0f / 1024.0f) + EPS);
                u32x2* o = (u32x2*)(XB + (size_t)m * 1024);
#pragma unroll
                for (int j = 0; j < 4; ++j) { u32x2 w; w.x = pk2(v[u][j][0] * rs, v[u][j][1] * rs); w.y = pk2(v[u][j][2] * rs, v[u][j][3] * rs); o[F.lane + 64 * j] = w; } } }
    }
    {
        float* scr = (float*)(F.lds + F.wave * 17408);
        constexpr int I_IN = 96 * 16, I_AB = 16, I_F = 16 * 8, I_D = 16 * 16;
        constexpr int NIT = I_IN + I_AB + I_F + I_D;
        for (int it = F.gw; it < NIT; it += F.ngw) {
            int r = it;
            if (r < I_IN) { const int nb = r >> 4, kb = r & 15, n0 = nb * 64; tr_item64(w_in, INW, kb * 64, n0 < 4096 ? n0 + 512 : n0 + 544, WTIN, 1024, n0, n0 + 32, g1, 1023, scr, F.lane); continue; } r -= I_IN;
            if (r < I_AB) { tr_item(w_in, INW, r * 64, 4608, (bf16*)(F.ws + WS_WAB), 1024, 0, g1, 1023, scr, F.lane); continue; } r -= I_AB;
            if (r < I_F) { const int nb = r >> 3, kb = r & 7; tr_item64(INP(10), 1024, kb * 64, nb * 64, (bf16*)(F.ws + WS_WF), 1536, nb * 64, nb * 64 + 32, nullptr, 0, scr, F.lane); continue; } r -= I_F;
            { const int nb = r >> 4, kb = r & 15; tr_item64(INP(11), 1024, kb * 64, nb * 64, (bf16*)(F.ws + WS_WF) + 512, 1536, nb * 64, nb * 64 + 32, INP(9), 127, scr, F.lane); }
        }
    }
    {
        float* WR = (float*)(F.ws + WS_WR); const float* g2 = INP(13); const float* wrg = INP(14); const float* wre = INP(16);
        for (int idx = F.gw * 64 + F.lane; idx < 72 * 1024; idx += F.ngw * 64) { const int j = idx >> 10, k = idx & 1023;
            WR[idx] = g2[k] * (j < 8 ? wrg[k * 8 + j] : wre[k * 64 + (j - 8)]); }
    }
    {
        bf16* XT = (bf16*)(F.ws + WS_XT);
        for (int idx = F.gw * 64 + F.lane; idx < 4096 * 12; idx += F.ngw * 64) { const int row = idx / 12, c = idx % 12;
            const int kap = c < 6 ? 2064 + 8 * c : 4176 + 8 * (c - 6);
            *(u32x4*)(XT + (size_t)row * KP + kap) = (u32x4){0u, 0u, 0u, 0u}; }
    }
    __syncthreads();
    for (int it = F.bid; it < 256; it += F.G) {
        const int g = it >> 6, k0 = (it & 63) * 16;
        float* Wl = (float*)F.lds; float* tc = Wl + 2048; float* tsn = tc + 128;
        { const int row = F.tid >> 5, c4 = (F.tid & 31) * 4; f32x4 v = *(const f32x4*)(w_in + (size_t)(k0 + row) * INW + g * 128 + c4); v *= g1[k0 + row]; *(f32x4*)(Wl + row * 128 + c4) = v; }
        if (F.tid < 128) { float s, c; sincospif((float)F.tid * (2.0f / 128.0f), &s, &c); tc[F.tid] = c; tsn[F.tid] = s; }
        __syncthreads();
        const int nl = F.tid & 255, kh = F.tid >> 8, mm = nl & 127; const float* tab = nl < 128 ? tc : tsn;
        float a[8];
#pragma unroll
        for (int j = 0; j < 8; ++j) a[j] = 0.f;
        for (int c = 0; c < 128; c += 4) { f32x4 tr;
#pragma unroll
            for (int e = 0; e < 4; ++e) tr[e] = tab[(mm * (c + e)) & 127];
#pragma unroll
            for (int j = 0; j < 8; ++j) { const f32x4 wv = *(const f32x4*)(Wl + (8 * kh + j) * 128 + c); a[j] += (wv[0] * tr[0] + wv[1] * tr[1]) + (wv[2] * tr[2] + wv[3] * tr[3]); } }
        const int np = (nl < 128 ? 0 : 512) + g * 128 + mm;
        u32x4 o; o.x = pk2(a[0], a[1]); o.y = pk2(a[2], a[3]); o.z = pk2(a[4], a[5]); o.w = pk2(a[6], a[7]);
        *(u32x4*)(WTIN + (size_t)(6144 + np) * 1024 + k0 + 8 * kh) = o;
        __syncthreads();
    }
    {
        float* tc = (float*)F.lds; float* tsn = tc + 2064; const float SC = __builtin_amdgcn_rsqf(2064.0f * 128.0f);
        for (int r = F.tid; r < 2064; r += 512) { float s, c; sincospif((float)r * (2.0f / 2064.0f), &s, &c); tc[r] = c * SC; tsn[r] = -s * SC; }
        __syncthreads();
        bf16* DM = (bf16*)(F.ws + WS_DM);
        const int nrows = (2048 - F.bid + F.G - 1) / F.G;
        for (int idx = F.tid; idx < nrows * (KP / 8); idx += 512) { const int ri = idx / (KP / 8), c8 = idx - ri * (KP / 8), i = F.bid + F.G * ri, k = 16 + i; float v[8];
            const int kap0 = c8 * 8; const float* tabp = nullptr; int m = 0;
            if (kap0 < 2064) { tabp = tc; m = (k * kap0) % 2064; } else if (kap0 >= KSIN && kap0 < KSIN + 2064) { tabp = tsn; m = (k * (kap0 - KSIN)) % 2064; }
#pragma unroll
            for (int e = 0; e < 8; ++e) { v[e] = tabp ? tabp[m] : 0.f; m += k; if (m >= 2064) m -= 2064; }
            u32x4 o; o.x = pk2(v[0], v[1]); o.y = pk2(v[2], v[3]); o.z = pk2(v[4], v[5]); o.w = pk2(v[6], v[7]);
            *(u32x4*)(DM + (size_t)i * KP + c8 * 8) = o; }
        __syncthreads();
    }
}

DI f32x4 mini_tile(const bf16* A16, const bf16* B16, int lane) {
    f32x4 acc = {0.f, 0.f, 0.f, 0.f};
    const bf16x8* ap = (const bf16x8*)(A16 + (lane & 15) * 1024 + 8 * (lane >> 4));
    const bf16x8* bp = (const bf16x8*)(B16 + (lane & 15) * 1024 + 8 * (lane >> 4));
#pragma unroll 8
    for (int kk = 0; kk < 32; ++kk) acc = __builtin_amdgcn_mfma_f32_16x16x32_bf16(ap[4 * kk], bp[4 * kk], acc, 0, 0, 0);
    return acc;
}
DI void phase_inproj(Ctx& F) {
    const bf16* XB = (const bf16*)(F.ws + WS_XB); const bf16* WTIN = (const bf16*)(F.ws + WS_WTIN); const float* RSTD1 = (const float*)(F.ws + WS_RSTD1);
    bf16* XT = (bf16*)(F.ws + WS_XT); bf16* QKVP = (bf16*)(F.ws + WS_QKVP); float* GB = (float*)(F.ws + WS_GB);
    const int q = F.lane >> 4, col = F.lane & 15;
    const bool mini_first = (F.vcu & 1) != 0;
#pragma unroll 1
    for (int pass = 0; pass < 2; ++pass) {
    if ((pass == 0) == mini_first) {
    for (int it = F.gw; it < 256 + 2050; it += F.ngw) {
        if (it < 256) {
            const int wrow = it < 64 ? 6144 + 16 * it : 16 * (it - 64);
            f32x4 acc = mini_tile(XB + (size_t)NTOK * 1024, WTIN + (size_t)wrow * 1024, F.lane);
            if (it < 64) { const int np = 16 * it + col; u32x2 w; w.x = pk2(acc[0], acc[1]); w.y = pk2(acc[2], acc[3]);
                for (int b = 0; b < NB; ++b) *(u32x2*)(XT + ((size_t)(b * 512 + (np & 511)) * KP + (np >= 512 ? KSIN : 0) + 4 * q)) = w; }
            else { const int n = 16 * (it - 64) + col;
                for (int b = 0; b < NB; ++b)
#pragma unroll
                    for (int r = 0; r < 4; ++r) { QKVP[(size_t)(b * LTOK + 4 * q + r) * 3072 + n] = (bf16)f2bf(acc[r]);
                        if (4 * q + r >= 14) ((bf16*)(F.ws + WS_HALO))[(size_t)((b * 32 + 0) * 4 + (4 * q + r - 14)) * 3072 + n] = (bf16)f2bf(acc[r]); } }
        } else {
            const int a = it - 256, rg = a >> 1, cgp = a & 1;
            f32x4 acc = mini_tile(XB + (size_t)rg * 16 * 1024, (const bf16*)(F.ws + WS_WAB) + (size_t)cgp * 16 * 1024, F.lane);
            const int j = cgp * 16 + col, ty = j >> 3, h = j & 7;
            const float alog = (ty & 2) ? INP(7)[h] : INP(5)[h], dtb = (ty & 2) ? INP(8)[h] : INP(6)[h];
#pragma unroll
            for (int r = 0; r < 4; ++r) { const int t = rg * 16 + 4 * q + r; const float v = acc[r];
                const float o = (ty & 1) ? sigm(v) : -__expf(alog) * softplusf(v + dtb);
                if (t < NTOK) GB[((size_t)(ty * NB + (t >> 11)) * NHEAD + h) * LTOK + 16 + (t & 2047)] = o;
                else for (int b = 0; b < NB; ++b) GB[((size_t)(ty * NB + b) * NHEAD + h) * LTOK + (t - NTOK)] = o; }
        }
    }
    }
    if (pass == 0) {
    __syncthreads();
    { pg8::Gemm g{WTIN + (size_t)6144 * 1024, XB, 1024}; pg8::StaticOrder S; S.init(1024, NTOK, F.G, F.bid); EpiXT E{XT, RSTD1};
      pg8::gemm_phase((PG8_LAS unsigned char*)F.lds, g, S, E, F.wave); }
    { pg8::Gemm g{XB, WTIN, 1024}; pg8::StaticOrder S; S.init(NTOK, 6144, F.G, F.bid);
      EpiIn E{QKVP, (bf16*)(F.ws + WS_Z), (bf16*)F.out, (bf16*)F.out + (size_t)NTOK * 1024, RSTD1, (bf16*)(F.ws + WS_HALO)};
      pg8::gemm_phase((PG8_LAS unsigned char*)F.lds, g, S, E, F.wave); }
    }
    }
}

DI int permpos(int d) { const int o = d & 31; return (d & ~31) + ((o >> 2) & 3) * 8 + (o >> 4) * 4 + (o & 3); }
DI float incl_scan(float v, int lane) {
#pragma unroll
    for (int o = 1; o < 64; o <<= 1) { const float t = __shfl_up(v, o); if (lane >= o) v += t; }
    return v;
}
DI void diag_inverse4(float* A, int lane) {
    const int blk = lane >> 4, c = lane & 15; float* N = A + (16 * blk) * 68 + 16 * blk;
    float t[16]; t[0] = c == 0 ? 1.f : 0.f;
#pragma unroll
    for (int i = 1; i < 16; ++i) { float acc = c == i ? 1.f : 0.f;
#pragma unroll
        for (int j4 = 0; j4 < (i + 3) / 4; ++j4) { const f32x4 a = *(const f32x4*)(N + i * 68 + 4 * j4);
#pragma unroll
            for (int e = 0; e < 4; ++e) if (4 * j4 + e < i) acc -= a[e] * t[4 * j4 + e]; }
        t[i] = acc; }
#pragma unroll
    for (int i = 0; i < 16; ++i) N[i * 68 + c] = t[i];
}
DI f32x4 blk_mma(const float* Ab, int lda, const float* Bb, int ldb, f32x4 acc, int lane) {
#pragma unroll
    for (int s4 = 0; s4 < 4; ++s4) acc = __builtin_amdgcn_mfma_f32_16x16x4f32(Ab[(lane & 15) * lda + 4 * s4 + (lane >> 4)], Bb[(4 * s4 + (lane >> 4)) * ldb + (lane & 15)], acc, 0, 0, 0);
    return acc;
}
DI void tri_inverse64_blocked(float* A4, float* xs, bool active, int wave, int lane) {
    float* A = A4 + (wave >> 1) * (64 * 68); const int w2 = wave & 1; float* X0 = xs + wave * 512; float* X1 = X0 + 256;
    if (active && w2 == 0) diag_inverse4(A, lane);
    __syncthreads();
#pragma unroll
    for (int I = 1; I < 4; ++I) {
        const int j0 = w2 == 0 ? 0 : 1;
        const int nj = w2 == 0 ? 1 : (I - 1);
        if (active) {
#pragma unroll
            for (int jj = 0; jj < 2; ++jj) { if (jj < nj) { const int j = j0 + jj; f32x4 x = {0.f, 0.f, 0.f, 0.f};
#pragma unroll
                for (int k = 0; k < 3; ++k) if (k >= j && k < I) x = blk_mma(A + (16 * I) * 68 + 16 * k, 68, A + (16 * k) * 68 + 16 * j, 68, x, lane);
                float* X = jj ? X1 : X0;
#pragma unroll
                for (int r = 0; r < 4; ++r) X[(4 * (lane >> 4) + r) * 16 + (lane & 15)] = x[r]; } }
        }
        __syncthreads();
        if (active) {
#pragma unroll
            for (int jj = 0; jj < 2; ++jj) { if (jj < nj) { const int j = j0 + jj; f32x4 y = {0.f, 0.f, 0.f, 0.f};
                y = blk_mma(A + (16 * I) * 68 + 16 * I, 68, jj ? X1 : X0, 16, y, lane);
#pragma unroll
                for (int r = 0; r < 4; ++r) A[(16 * I + 4 * (lane >> 4) + r) * 68 + 16 * j + (lane & 15)] = -y[r]; } }
        }
        __syncthreads();
    }
}

constexpr int PL_P = 0, PL_Q = 52224, PL_K = 69632, PL_A = 87040, PL_G = 156672;
struct PRegs { u32x4 v[7]; };
DI void prep_load_regs(Ctx& F, int it, PRegs& R) {
    const int tid0 = F.wave * 64 + lane_id();
    const int bh = it / 33, cc = it - bh * 33, b = bh >> 3, h = bh & 7, l0 = 64 * cc - 48;
    const bf16* qkv = (const bf16*)(F.ws + WS_QKVP) + (size_t)b * LTOK * 3072; const bf16* halo = (const bf16*)(F.ws + WS_HALO) + (size_t)b * 32 * 4 * 3072;
#pragma unroll
    for (int n = 0; n < 7; ++n) { const int idx = tid0 + 512 * n; u32x4 v = {0u, 0u, 0u, 0u};
        if (idx < 68 * 48) { const int pr = idx / 48, rem = idx - pr * 48, part = rem >> 4, c16 = rem & 15, l = l0 - 2 + pr, chb = part * 1024 + h * 128;
            if (pr < 2) { if (cc >= 1) v = *(const u32x4*)(halo + ((size_t)((cc - 1) * 4 + pr) * 3072 + chb + 8 * c16)); }
            else if (pr >= 66) { if (cc <= 31) v = *(const u32x4*)(halo + ((size_t)(cc * 4 + pr - 64) * 3072 + chb + 8 * c16)); }
            else if (l >= 0) v = *(const u32x4*)(qkv + ((size_t)l * 3072 + chb + 8 * c16)); }
        R.v[n] = v; }
}
DI void prep_store_regs(Ctx& F, const PRegs& R) {
    bf16* P = (bf16*)(F.lds + 0); const int tid0 = F.wave * 64 + lane_id();
#pragma unroll
    for (int n = 0; n < 7; ++n) { const int idx = tid0 + 512 * n;
        if (idx < 68 * 48) { const int pr = idx / 48, rem = idx - pr * 48, part = rem >> 4, c16 = rem & 15; *(u32x4*)(P + (part * 68 + pr) * 128 + 8 * c16) = R.v[n]; } }
}
DI void prep_item_conv(Ctx& F, int b, int h, int cc, int slot) {
    bf16* qkv = (bf16*)(F.ws + WS_QKVP) + (size_t)b * LTOK * 3072;
    const float* cw = INP(4); const float* GB = (const float*)(F.ws + WS_GB);
    bf16* P = (bf16*)(F.lds + PL_P); bf16* Qs = (bf16*)(F.lds + PL_Q); bf16* Ks = (bf16*)(F.lds + PL_K);
    float* Gs = (float*)(F.lds + PL_G) + slot * 256; float* Bs = Gs + 128;
    const int lane = lane_id(), wave = F.wave, l0 = 64 * cc - 48;
    if (wave < 2) { const int isrc = wave ? 63 - lane : lane; const int l = l0 + isrc; float g = 0.f, be = 0.f;
        if (l >= 0) { g = GB[((size_t)((wave * 2) * NB + b) * NHEAD + h) * LTOK + l]; be = GB[((size_t)((wave * 2 + 1) * NB + b) * NHEAD + h) * LTOK + l]; }
        const float gc = incl_scan(g, lane); Gs[wave * 64 + lane] = gc; Bs[wave * 64 + lane] = be;
        if (!F.dry) ((float*)(F.ws + WS_GCUM))[((size_t)(wave * 64 + b * NHEAD + h) * 33 + cc) * 64 + lane] = gc; }
    const int c16 = lane & 15, r4 = lane >> 4;
    f32x4 wall[3][5][2];
#pragma unroll
    for (int part = 0; part < 3; ++part)
#pragma unroll
        for (int j = 0; j < 5; ++j) { const float* wp = cw + j * 3072 + part * 1024 + h * 128 + 8 * c16; wall[part][j][0] = *(const f32x4*)wp; wall[part][j][1] = *(const f32x4*)(wp + 4); }
    __syncthreads();
    {
#pragma unroll
      for (int part = 0; part < 3; ++part) { const int chb = part * 1024 + h * 128;
          f32x4 w[5][2];
#pragma unroll
          for (int j = 0; j < 5; ++j) { w[j][0] = wall[part][j][0]; w[j][1] = wall[part][j][1]; }
#pragma unroll
          for (int it2 = 0; it2 < 2; ++it2) { const int i = wave * 8 + it2 * 4 + r4, l = l0 + i;
              f32x4 a0 = {0.f, 0.f, 0.f, 0.f}, a1 = {0.f, 0.f, 0.f, 0.f};
#pragma unroll
              for (int j = 0; j < 5; ++j) { f32x4 p0, p1; unpack8(*(const u32x4*)(P + (part * 68 + i + j) * 128 + 8 * c16), p0, p1); a0 += p0 * w[j][0]; a1 += p1 * w[j][1]; }
#pragma unroll
              for (int e = 0; e < 4; ++e) { a0[e] = siluf(a0[e]); a1[e] = siluf(a1[e]); }
              if (part < 2) { float ss = (a0[0] * a0[0] + a0[1] * a0[1]) + (a0[2] * a0[2] + a0[3] * a0[3]) + (a1[0] * a1[0] + a1[1] * a1[1]) + (a1[2] * a1[2] + a1[3] * a1[3]);
                  ss += __shfl_xor(ss, 1); ss += __shfl_xor(ss, 2); ss += __shfl_xor(ss, 4); ss += __shfl_xor(ss, 8);
                  const float rn = (part == 0 ? 0.08838834764831845f : 1.0f) * __builtin_amdgcn_rsqf(ss + EPS); a0 *= rn; a1 *= rn; }
              const u32x4 o = pack8(a0, a1);
              if (l >= 0 && !F.dry) *(u32x4*)(qkv + ((size_t)l * 3072 + chb + 8 * c16)) = o;
              if (part == 0) *(u32x4*)(Qs + i * 136 + 8 * c16) = o; else if (part == 1) *(u32x4*)(Ks + i * 136 + 8 * c16) = o; } } }
    __syncthreads();
}
DI void prep_item_gram(Ctx& F, int b, int h, int cc, int slot) {
    bf16* Qs = (bf16*)(F.lds + PL_Q); bf16* Ks = (bf16*)(F.lds + PL_K);
    float* Gs = (float*)(F.lds + PL_G) + slot * 256; float* Bs = Gs + 128;
    const int lane = lane_id(), wave = F.wave, tid = wave * 64 + lane;
    float* Af = (float*)(F.lds + PL_A) + (slot * 2 + 0) * (64 * 68); float* Ab = Af + 64 * 68;
    bf16* QKfi = (bf16*)(F.lds + PL_P); bf16* QKbi = QKfi + 4096;
    for (int tt = 0; tt < 4; ++tt) { const int id = wave * 4 + tt, which = id >> 4, mt = (id >> 2) & 3, nt = id & 3;
        const bf16* Ap = (which ? Qs : Ks) + (16 * mt + (lane & 15)) * 136 + 8 * (lane >> 4); const bf16* Bp = Ks + (16 * nt + (lane & 15)) * 136 + 8 * (lane >> 4);
        f32x4 acc = {0.f, 0.f, 0.f, 0.f};
#pragma unroll
        for (int kk = 0; kk < 4; ++kk) acc = __builtin_amdgcn_mfma_f32_16x16x32_bf16(*(const bf16x8*)(Ap + 32 * kk), *(const bf16x8*)(Bp + 32 * kk), acc, 0, 0, 0);
        const int j = 16 * nt + (lane & 15), jb = 63 - j; const float gfj = Gs[j], gbj = Gs[64 + jb];
#pragma unroll
        for (int r = 0; r < 4; ++r) { const int i = 16 * mt + 4 * (lane >> 4) + r, ib = 63 - i;
            const float df = __expf(Gs[i] - gfj), db = __expf(Gs[64 + ib] - gbj);
            if (which == 0) { Af[i * 68 + j] = (i > j) ? Bs[i] * acc[r] * df : 0.f; Ab[ib * 68 + jb] = (ib > jb) ? Bs[64 + ib] * acc[r] * db : 0.f; }
            else { QKfi[i * 64 + permpos(j)] = (bf16)f2bf((i >= j) ? acc[r] * df : 0.f); QKbi[ib * 64 + permpos(jb)] = (bf16)f2bf((ib >= jb) ? acc[r] * db : 0.f); } } }
    __syncthreads();
    { bf16* outp = (bf16*)(F.ws + WS_TQK) + ((size_t)(b * NHEAD + h) * 65) * 8192;
      const int i = tid >> 3, c = tid & 7;
      if (!F.dry) *(u32x4*)(outp + (size_t)cc * 8192 + 4096 + i * 64 + 8 * c) = *(const u32x4*)(QKfi + i * 64 + 8 * c);
      if (cc > 0 && !F.dry) *(u32x4*)(outp + (size_t)(32 + cc) * 8192 + 4096 + i * 64 + 8 * c) = *(const u32x4*)(QKbi + i * 64 + 8 * c); }
    __syncthreads();
}
DI void prep_tail(Ctx& F, int it0) {
    { const int m = F.wave >> 1, k = m >> 1, dir = m & 1; const int cc = (it0 + k) % 33;
      tri_inverse64_blocked((float*)(F.lds + PL_A), (float*)(F.lds + PL_P), !(dir == 1 && cc == 0), F.wave, F.lane); }
    { const int m = F.tid >> 7, i = (F.tid & 127) >> 1, half = F.tid & 1, k = m >> 1, dir = m & 1; const int it = it0 + k, bh = it / 33, cc = it % 33;
      if (!(dir == 1 && cc == 0) && !F.dry) { const float* A = (const float*)(F.lds + PL_A) + m * (64 * 68) + i * 68 + 32 * half;
          bf16* dst = (bf16*)(F.ws + WS_TQK) + ((size_t)bh * 65 + (dir ? 32 + cc : cc)) * 8192 + i * 64 + 32 * half;
#pragma unroll
          for (int qq = 0; qq < 4; ++qq) { u32x4 o; o.x = pk2(A[4 * qq + 0], A[4 * qq + 1]); o.y = pk2(A[4 * qq + 2], A[4 * qq + 3]); o.z = pk2(A[16 + 4 * qq + 0], A[16 + 4 * qq + 1]); o.w = pk2(A[16 + 4 * qq + 2], A[16 + 4 * qq + 3]);
              *(u32x4*)(dst + 8 * qq) = o; } } }
    __syncthreads();
}
DI void phase_dft_prep(Ctx& F) {
    { pg8::Gemm g{(const bf16*)(F.ws + WS_DM), (const bf16*)(F.ws + WS_XT), KP}; pg8::DftOrder S{F.G, F.vcu}; EpiPlain E{(bf16*)(F.ws + WS_FM), 512};
      pg8::gemm_phase((PG8_LAS unsigned char*)F.lds, g, S, E, F.wave); }
    volatile int* qs = (volatile int*)(F.lds + LDS_BARW + 64);
    constexpr int NR = (64 * 33) / 2;
    unsigned* qhead = F.ctl + CW_PREPQ + (F.dry ? 64 : 0);
    if (F.tid == 0) qs[0] = (int)atomicAdd(qhead, 1u);
    __syncthreads();
    int rd = qs[0];
    PRegs pr;
    if (rd < NR) prep_load_regs(F, 2 * rd, pr);
    while (rd < NR) {
        const int it0 = 2 * rd;
        if (F.tid == 0) qs[1] = (int)atomicAdd(qhead, 1u);
        int rdn = NR;
#pragma unroll 1
        for (int k = 0; k < 2; ++k) {
            prep_store_regs(F, pr);
            if (k == 0) prep_load_regs(F, it0 + 1, pr);
            else { rdn = qs[1]; if (rdn < NR) prep_load_regs(F, 2 * rdn, pr); }
            const int it = it0 + k, bh = it / 33, cc = it - bh * 33;
            prep_item_conv(F, bh >> 3, bh & 7, cc, k); prep_item_gram(F, bh >> 3, bh & 7, cc, k);
        }
        prep_tail(F, it0);
        rd = rdn;
    }
}

DI bf16x8 packB(f32x4 lo, f32x4 hi) { return __builtin_bit_cast(bf16x8, pack8(lo, hi)); }
typedef short s16x4 __attribute__((ext_vector_type(4)));
constexpr int SB_K = 0, SB_Q = 16384, SB_V = 32768, SB_T = 49152, SB_QK = 57344, SB_BYTES = 65536;
DI void scan_dma(Ctx& F, unsigned char* buf, const bf16* qkv  , const bf16* zero, const bf16* tq, int h, int dir, int cc, int half) {
    const int lane = F.lane, wave = F.wave - 4, l0 = 64 * cc - 48;
#pragma unroll
    for (int n2 = 0; n2 < 4; ++n2) { const int n = 4 * wave + n2, row = 4 * n + (lane >> 4), cl = lane & 15, cg = cl ^ (row & 15);
        const int l = l0 + (dir ? 63 - row : row);
#pragma unroll
        for (int part = 0; part < 2; ++part) { const bf16* src = l >= 0 ? qkv + ((size_t)l * 3072 + part * 1024 + h * 128 + 8 * cg) : zero;
            const int boff = (part == 0 ? SB_Q : SB_K) + n * 1024;
            __builtin_amdgcn_global_load_lds((const unsigned*)src, (LAS unsigned*)((LAS unsigned char*)buf + boff), 16, 0, 0); } }
#pragma unroll
    for (int n2 = 0; n2 < 2; ++n2) { const int n = 2 * wave + n2, row = 8 * n + (lane >> 3), cl = lane & 7, cg = cl ^ ((row >> 1) & 7);
      const int l = l0 + (dir ? 63 - row : row);
      const bf16* vsrc = l >= 0 ? qkv + ((size_t)l * 3072 + 2048 + h * 128 + 64 * half + 8 * cg) : zero;
      __builtin_amdgcn_global_load_lds((const unsigned*)vsrc, (LAS unsigned*)((LAS unsigned char*)buf + SB_V + n * 1024), 16, 0, 0);
      const bf16* Tg = tq + (size_t)(dir ? 32 + cc : cc) * 8192;
      __builtin_amdgcn_global_load_lds((const unsigned*)(Tg + row * 64 + 8 * cg), (LAS unsigned*)((LAS unsigned char*)buf + SB_T + n * 1024), 16, 0, 0);
      __builtin_amdgcn_global_load_lds((const unsigned*)(Tg + 4096 + row * 64 + 8 * cg), (LAS unsigned*)((LAS unsigned char*)buf + SB_QK + n * 1024), 16, 0, 0); }
}
constexpr int SB_OST = 131072, SB_ROW = 147456;
DI void scan_flush(Ctx& F, bf16* Og, int b, int h, int dir, int cc, int half, int stg) {
#pragma unroll
    for (int i = 0; i < 2; ++i) { const int tq = F.tid - 256, row = (tq >> 3) + 32 * i, c = tq & 7, isrc = dir ? 63 - row : row; const int t = b * SEQ + 64 * (cc - 1) + isrc;
        *(u32x4*)(Og + (size_t)t * 1024 + h * 128 + 64 * half + 8 * c) = *(const u32x4*)(F.lds + SB_OST + stg * 8192 + row * 128 + c * 16); }
}
DI void scan_chain(Ctx& F, int b, int h, int dir, int half) {
    const bf16* qkv = (const bf16*)(F.ws + WS_QKVP) + (size_t)b * LTOK * 3072; const float* GB = (const float*)(F.ws + WS_GB);
    const bf16* zero = (const bf16*)(F.ctl + CW_ZERO); const bf16* tq = (const bf16*)(F.ws + WS_TQK) + ((size_t)(b * NHEAD + h) * 65) * 8192;
    bf16* Og = (bf16*)(F.ws + (dir ? WS_OB : WS_OF));
    const int lane = F.lane, wave = F.wave, q = lane >> 4, col = lane & 15, dvl = 16 * (wave & 3) + col; const bool cw = wave < 4;
    const float* gC = (const float*)(F.ws + WS_GCUM) + ((size_t)(dir * 64 + b * NHEAD + h) * 33) * 64; const float* gBe = GB + ((size_t)((dir * 2 + 1) * NB + b) * NHEAD + h) * LTOK;
#define SCAN_ROWS(stp) ((float*)(F.lds + SB_ROW + ((stp) & 1) * 1024))
    f32x4 S[8];
#pragma unroll
    for (int i = 0; i < 8; ++i) S[i] = (f32x4){0.f, 0.f, 0.f, 0.f};
    const int nsteps = dir ? 32 : 33;
#define SCAN_FILL(ccx, stp) do { const int l_ = 64 * (ccx) - 48 + (dir ? 63 - lane : lane); const float g_ = gC[(ccx) * 64 + lane]; float be_ = 0.f; if (l_ >= 0) be_ = gBe[l_]; \
        const float gl_ = __shfl(g_, 63); float* rw_ = SCAN_ROWS(stp); rw_[lane] = __expf(g_); rw_[64 + lane] = __expf(gl_ - g_); rw_[128 + lane] = be_; if (lane == 0) rw_[192] = __expf(gl_); } while (0)
    { const int cc = dir ? 32 : 0; if (wave == 4) SCAN_FILL(cc, 0); if (!cw) scan_dma(F, F.lds, qkv, zero, tq, h, dir, cc, half); }
    VM_WAIT(); __syncthreads();
    int ccprev = 0;
    for (int st = 0; st < nsteps; ++st) {
        const int cc = dir ? 32 - st : st;
        unsigned char* buf = F.lds + (st & 1) * SB_BYTES;
        if (!cw) {
            if (st + 1 < nsteps) { const int ccn = dir ? 32 - (st + 1) : st + 1; if (wave == 4) SCAN_FILL(ccn, st + 1); scan_dma(F, F.lds + ((st + 1) & 1) * SB_BYTES, qkv, zero, tq, h, dir, ccn, half); }
            if (ccprev > 0) scan_flush(F, Og, b, h, dir, ccprev, half, (st + 1) & 1); }
        LDS_WAIT();
        f32x4 O[4], VN[4]; float eD[4][4]; float dec = 0.f;
        if (cw) {
            const float* rowsc = SCAN_ROWS(st); dec = rowsc[192];
            float eG[4][4], be[4][4];
#pragma unroll
            for (int mt = 0; mt < 4; ++mt) { const f32x4 g4 = *(const f32x4*)(rowsc + 16 * mt + 4 * q), d4 = *(const f32x4*)(rowsc + 64 + 16 * mt + 4 * q), b4 = *(const f32x4*)(rowsc + 128 + 16 * mt + 4 * q);
#pragma unroll
                for (int r = 0; r < 4; ++r) { eG[mt][r] = g4[r]; eD[mt][r] = d4[r]; be[mt][r] = b4[r]; } }
            bf16x8 bS[4];
#pragma unroll
            for (int ks = 0; ks < 4; ++ks) bS[ks] = packB(S[2 * ks], S[2 * ks + 1]);
            f32x4 R[4];
#pragma unroll
            for (int mt = 0; mt < 4; ++mt) { const int row = 16 * mt + col; f32x4 Pm = {0.f, 0.f, 0.f, 0.f}; O[mt] = (f32x4){0.f, 0.f, 0.f, 0.f};
#pragma unroll
                for (int ks = 0; ks < 4; ++ks) { const int off = row * 256 + (((4 * ks + q) ^ (row & 15)) << 4);
                    Pm = __builtin_amdgcn_mfma_f32_16x16x32_bf16(*(const bf16x8*)(buf + SB_K + off), bS[ks], Pm, 0, 0, 0);
                    O[mt] = __builtin_amdgcn_mfma_f32_16x16x32_bf16(*(const bf16x8*)(buf + SB_Q + off), bS[ks], O[mt], 0, 0, 0); }
#pragma unroll
                for (int r = 0; r < 4; ++r) { const int c = 16 * mt + 4 * q + r;
                    const float v = bf2f(*(const bf16*)(buf + SB_V + c * 128 + ((((dvl >> 3) ^ ((c >> 1) & 7)) << 4) + (dvl & 7) * 2)));
                    R[mt][r] = be[mt][r] * (v - eG[mt][r] * Pm[r]); O[mt][r] *= eG[mt][r]; } }
            bf16x8 bR[2] = {packB(R[0], R[1]), packB(R[2], R[3])};
#pragma unroll
            for (int mt = 0; mt < 4; ++mt) { const int row = 16 * mt + col; VN[mt] = (f32x4){0.f, 0.f, 0.f, 0.f};
#pragma unroll
                for (int ks = 0; ks < 2; ++ks) { if (mt < 2 && ks == 1) continue; const int off = row * 128 + (((4 * ks + q) ^ ((row >> 1) & 7)) << 4);
                    VN[mt] = __builtin_amdgcn_mfma_f32_16x16x32_bf16(*(const bf16x8*)(buf + SB_T + off), bR[ks], VN[mt], 0, 0, 0); } }
            bf16x8 bV[2] = {packB(VN[0], VN[1]), packB(VN[2], VN[3])};
#pragma unroll
            for (int mt = 0; mt < 4; ++mt) { const int row = 16 * mt + col;
#pragma unroll
                for (int ks = 0; ks < 2; ++ks) { if (mt < 2 && ks == 1) continue; const int off = row * 128 + (((4 * ks + q) ^ ((row >> 1) & 7)) << 4);
                    O[mt] = __builtin_amdgcn_mfma_f32_16x16x32_bf16(*(const bf16x8*)(buf + SB_QK + off), bV[ks], O[mt], 0, 0, 0); } }
        }
        if (cw) {
            if (cc > 0) {
#pragma unroll
                for (int mt = 0; mt < 4; ++mt)
#pragma unroll
                    for (int r = 0; r < 4; ++r) *(bf16*)(F.lds + SB_OST + (st & 1) * 8192 + (16 * mt + 4 * q + r) * 128 + dvl * 2) = (bf16)f2bf(O[mt][r]); }
#pragma unroll
            for (int mt = 0; mt < 4; ++mt)
#pragma unroll
                for (int r = 0; r < 4; ++r) VN[mt][r] *= eD[mt][r];
            bf16x8 bD[2] = {packB(VN[0], VN[1]), packB(VN[2], VN[3])};
            const int rp = (lane >> 2) & 3, p = lane & 3;
            const unsigned kbase = (unsigned)(size_t)(LAS unsigned char*)(buf + SB_K);
#pragma unroll
            for (int th = 0; th < 4; ++th) {
                const unsigned addr = kbase + (unsigned)((4 * q + rp) * 256 + 64 * (th ^ q) + 16 * (p ^ rp));
                s16x4 f0, f1, f2, f3, f4, f5, f6, f7;
                asm volatile("ds_read_b64_tr_b16 %0, %8\n\tds_read_b64_tr_b16 %1, %8 offset:4096\n\tds_read_b64_tr_b16 %2, %8 offset:8192\n\tds_read_b64_tr_b16 %3, %8 offset:12288\n\t"
                             "ds_read_b64_tr_b16 %4, %8 offset:8\n\tds_read_b64_tr_b16 %5, %8 offset:4104\n\tds_read_b64_tr_b16 %6, %8 offset:8200\n\tds_read_b64_tr_b16 %7, %8 offset:12296\n\ts_waitcnt lgkmcnt(0)"
                             : "=&v"(f0), "=&v"(f1), "=&v"(f2), "=&v"(f3), "=&v"(f4), "=&v"(f5), "=&v"(f6), "=&v"(f7) : "v"(addr) : "memory");
                const bf16x8 a00 = __builtin_shufflevector(f0, f1, 0, 1, 2, 3, 4, 5, 6, 7), a01 = __builtin_shufflevector(f2, f3, 0, 1, 2, 3, 4, 5, 6, 7);
                const bf16x8 a10 = __builtin_shufflevector(f4, f5, 0, 1, 2, 3, 4, 5, 6, 7), a11 = __builtin_shufflevector(f6, f7, 0, 1, 2, 3, 4, 5, 6, 7);
                S[2 * th] *= dec; S[2 * th + 1] *= dec;
                S[2 * th] = __builtin_amdgcn_mfma_f32_16x16x32_bf16(a00, bD[0], S[2 * th], 0, 0, 0); S[2 * th] = __builtin_amdgcn_mfma_f32_16x16x32_bf16(a01, bD[1], S[2 * th], 0, 0, 0);
                S[2 * th + 1] = __builtin_amdgcn_mfma_f32_16x16x32_bf16(a10, bD[0], S[2 * th + 1], 0, 0, 0); S[2 * th + 1] = __builtin_amdgcn_mfma_f32_16x16x32_bf16(a11, bD[1], S[2 * th + 1], 0, 0, 0);
            }
        }
        ccprev = cc;
        VM_WAIT(); __syncthreads();
    }
    if (!cw && ccprev > 0) scan_flush(F, Og, b, h, dir, ccprev, half, (nsteps + 1) & 1);
    __syncthreads();
#undef SCAN_ROWS
#undef SCAN_FILL
}
DI void phase_scan(Ctx& F) { for (int it = F.bid; it < 256; it += F.G) { const int ch = it & 127; scan_chain(F, ch >> 4, (ch >> 1) & 7, ch & 1, it >> 7); } }

DI void phase_og_wexp(Ctx& F) {
    bf16* OF = (bf16*)(F.ws + WS_OF); const bf16* OB = (const bf16*)(F.ws + WS_OB); const bf16* Z = (const bf16*)(F.ws + WS_Z);
    for (int t = F.gw; t < NTOK; t += F.ngw) { const size_t o = (size_t)t * 1024 + 16 * F.lane; float v[16]; float ss = 0.f;
#pragma unroll
        for (int hh = 0; hh < 2; ++hh) { f32x4 a0, a1, b0, b1; unpack8(*(const u32x4*)(OF + o + 8 * hh), a0, a1); unpack8(*(const u32x4*)(OB + o + 8 * hh), b0, b1); a0 += b0; a1 += b1;
#pragma unroll
            for (int j = 0; j < 4; ++j) { v[8 * hh + j] = a0[j]; v[8 * hh + 4 + j] = a1[j]; ss += a0[j] * a0[j] + a1[j] * a1[j]; } }
        ss += __shfl_xor(ss, 1); ss += __shfl_xor(ss, 2); ss += __shfl_xor(ss, 4);
        const float rs = __builtin_amdgcn_rsqf(ss * (1.0f / 128.0f) + EPS);
#pragma unroll
        for (int hh = 0; hh < 2; ++hh) { f32x4 z0, z1; unpack8(*(const u32x4*)(Z + o + 8 * hh), z0, z1); f32x4 a0, a1;
#pragma unroll
            for (int j = 0; j < 4; ++j) { a0[j] = v[8 * hh + j] * rs * siluf(z0[j]); a1[j] = v[8 * hh + 4 + j] * rs * siluf(z1[j]); }
            if (!F.dry) *(u32x4*)(OF + o + 8 * hh) = pack8(a0, a1); } }
    float* scr = (float*)(F.lds + F.wave * 17408); const float* g2 = INP(13);
    for (int it = F.gw; it < 64 * 192 + 256; it += F.ngw) { const int e = it / 192, r = it % 192;
        if (it >= 64 * 192) { const int q = it - 64 * 192, nb = q >> 4, kb = q & 15;
            tr_item64(INP(12), 1024, kb * 64, nb * 64, (bf16*)(F.ws + WS_WO), 1024, nb * 64, nb * 64 + 32, nullptr, 0, scr, F.lane, F.dry); continue; }
        if (r < 128) { const int up = r >> 6, rr = r & 63, nb = rr >> 4, kb = rr & 15, j0 = nb * 64; const int d0 = 256 * (j0 >> 7) + 128 * up + (j0 & 127);
            tr_item64((up ? INP(19) : INP(18)) + (size_t)e * 1024 * 256, 256, kb * 64, j0, (bf16*)(F.ws + WS_WGU) + (size_t)e * 512 * 1024, 1024, d0, d0 + 32, g2, 1023, scr, F.lane, F.dry); }
        else { const int rr = r - 128, nb = rr >> 2, kb = rr & 3;
            tr_item64(INP(20) + (size_t)e * 256 * 1024, 1024, kb * 64, nb * 64, (bf16*)(F.ws + WS_WDN) + (size_t)e * 1024 * 256, 256, nb * 64, nb * 64 + 32, nullptr, 0, scr, F.lane, F.dry); } }
    __syncthreads();
}

DI void phase_merge(Ctx& F) {
    bf16* MG = (bf16*)(F.ws + WS_OB); const unsigned char* GF8 = (const unsigned char*)F.out; const unsigned char* GD8 = GF8 + (size_t)NTOK * 1024 * 2;
    pg8::Gemm2 g{(const bf16*)(F.ws + WS_FM), 512, (const bf16*)(F.ws + WS_OF), 1024, (const bf16*)(F.ws + WS_WF)};
    pg8::StaticOrder S; S.init(NTOK, 1024, F.G, F.bid); EpiMerge2 E{MG, GF8, GD8};
    pg8::gemm_phase_dual((PG8_LAS unsigned char*)F.lds, g, S, E, F.wave);
}
DI void phase_outproj(Ctx& F) {
    pg8::Gemm g{(const bf16*)(F.ws + WS_OB), (const bf16*)(F.ws + WS_WO), 1024}; pg8::StaticOrder S; S.init(NTOK, 1024, F.G, F.bid); EpiOut E{INP(0), F.out};
    pg8::gemm_phase((PG8_LAS unsigned char*)F.lds, g, S, E, F.wave);
}

DI void phase_router(Ctx& F) {
    const float* H2 = F.out; const float* WR = (const float*)(F.ws + WS_WR); bf16* XN = (bf16*)(F.ws + WS_XN); int* rowtok = (int*)(F.ws + WS_ROWTOK); int* tokinfo = (int*)(F.ws + WS_TOKINFO);
    const float* brg = INP(15); const float* bre = INP(17);
    int tp = -1, pea = 0, peb = 0, ppa = 0, ppb = 0; float pw1 = 0.f, pw2 = 0.f;
    for (int t = F.gw; t < NTOK; t += F.ngw) {
        f32x4 xv[4]; float ss = 0.f;
#pragma unroll
        for (int j = 0; j < 4; ++j) { xv[j] = ((const f32x4*)(H2 + (size_t)t * 1024))[F.lane + 64 * j]; ss += (xv[j][0] * xv[j][0] + xv[j][1] * xv[j][1]) + (xv[j][2] * xv[j][2] + xv[j][3] * xv[j][3]); }
        ss = wave_sum(ss); const float rs = __builtin_amdgcn_rsqf(ss * (1.0f / 1024.0f) + EPS);
        if (!F.dry) { u32x2* o = (u32x2*)(XN + (size_t)t * 1024);
#pragma unroll
            for (int j = 0; j < 4; ++j) { u32x2 w; w.x = pk2(xv[j][0] * rs, xv[j][1] * rs); w.y = pk2(xv[j][2] * rs, xv[j][3] * rs); o[F.lane + 64 * j] = w; } }
        float gl[8];
#pragma unroll
        for (int jj = 0; jj < 8; ++jj) { float p = 0.f;
#pragma unroll
            for (int j = 0; j < 4; ++j) { const f32x4 w = ((const f32x4*)(WR + (size_t)jj * 1024))[F.lane + 64 * j]; p += (xv[j][0] * w[0] + xv[j][1] * w[1]) + (xv[j][2] * w[2] + xv[j][3] * w[3]); }
            gl[jj] = p; }
        wave_sum8(gl);
#pragma unroll
        for (int jj = 0; jj < 8; ++jj) gl[jj] = gl[jj] * rs + brg[jj];
        int gi = 0; float gm = gl[0];
#pragma unroll
        for (int jj = 1; jj < 8; ++jj) if (gl[jj] > gm) { gm = gl[jj]; gi = jj; }
        float den = 0.f;
#pragma unroll
        for (int jj = 0; jj < 8; ++jj) den += __expf(gl[jj] - gm);
        const float pg = 1.0f / den;
        gi = __builtin_amdgcn_readfirstlane(gi);
        float el[8];
#pragma unroll
        for (int jj = 0; jj < 8; ++jj) { float p = 0.f; const float* wrow = WR + (size_t)(8 + gi * 8 + jj) * 1024;
#pragma unroll
            for (int j = 0; j < 4; ++j) { const f32x4 w = ((const f32x4*)wrow)[F.lane + 64 * j]; p += (xv[j][0] * w[0] + xv[j][1] * w[1]) + (xv[j][2] * w[2] + xv[j][3] * w[3]); }
            el[jj] = p; }
        wave_sum8(el);
#pragma unroll
        for (int jj = 0; jj < 8; ++jj) el[jj] = el[jj] * rs + bre[gi * 8 + jj];
        int i1 = 0; float m1 = el[0];
#pragma unroll
        for (int jj = 1; jj < 8; ++jj) if (el[jj] > m1) { m1 = el[jj]; i1 = jj; }
        int i2 = -1; float m2 = -3.0e38f;
#pragma unroll
        for (int jj = 0; jj < 8; ++jj) if (jj != i1 && el[jj] > m2) { m2 = el[jj]; i2 = jj; }
        const float e2 = __expf(m2 - m1), w1 = pg / (1.0f + e2), w2 = pg * e2 / (1.0f + e2);
        if (F.lane == 0 && !F.dry) {
            if (tp >= 0) { rowtok[pea * MOE_CAP + ppa] = tp; rowtok[peb * MOE_CAP + ppb] = tp;
                int* ti = tokinfo + 4 * tp; ti[0] = pea * MOE_CAP + ppa; ti[1] = __builtin_bit_cast(int, pw1); ti[2] = peb * MOE_CAP + ppb; ti[3] = __builtin_bit_cast(int, pw2); }
            pea = gi * 8 + i1; peb = gi * 8 + i2; pw1 = w1; pw2 = w2; tp = t;
            ppa = (int)atomicAdd(F.ctl + CW_CNT + 64 * pea, 1u); ppb = (int)atomicAdd(F.ctl + CW_CNT + 64 * peb, 1u); }
    }
    if (F.lane == 0 && !F.dry && tp >= 0) { rowtok[pea * MOE_CAP + ppa] = tp; rowtok[peb * MOE_CAP + ppb] = tp;
        int* ti = tokinfo + 4 * tp; ti[0] = pea * MOE_CAP + ppa; ti[1] = __builtin_bit_cast(int, pw1); ti[2] = peb * MOE_CAP + ppb; ti[3] = __builtin_bit_cast(int, pw2); }
}
DI void phase_experts(Ctx& F) {
    LAS int* tab = (LAS int*)((LAS unsigned char*)F.lds + LDS_MOETAB);
    if (F.wave == 0) {
        const int e = F.lane; const int c = (int)F.ctl[CW_CNT + 64 * e]; const int nte = (c + 255) >> 8;
        const int incl = (int)incl_scan((float)nte, F.lane);
        const int run0 = incl - nte;
        for (int i = 0; i < nte; ++i) { tab[run0 + i] = e; tab[256 + run0 + i] = e * MOE_CAP + i * 256; tab[512 + run0 + i] = (c - i * 256) < 256 ? (c - i * 256) : 256; }
        if (F.lane == 63) tab[768] = incl; }
    __syncthreads();
    const int ntiles = tab[768];
    {
        pg8::Gemm g{(const bf16*)(F.ws + WS_XN), (const bf16*)(F.ws + WS_WGU), 1024};
        pg8::MoeOrder S{ntiles * 2, 2, F.G, F.vcu, tab, F.ctl + CW_READY}; EpiGU E{(bf16*)(F.ws + WS_HACT)};
        pg8::gemm_phase_gather((PG8_LAS unsigned char*)F.lds, g, (const int*)(F.ws + WS_ROWTOK), S, E, F.wave);
    }
    {
        const int G = F.G, D = ntiles * 4, n2 = 2 * ntiles > G ? 2 * ntiles - G : 0;
        const int D1 = 4 * (ntiles < G / 2 ? ntiles : G / 2), D2 = D - D1;
        int first, count;
        if (F.vcu >= n2) { const int G1 = G - n2, j = F.vcu - n2, base = D1 / G1, extra = D1 - base * G1; count = base + (j < extra ? 1 : 0); first = j * base + (j < extra ? j : extra); }
        else { const int j = F.vcu, base = D2 / n2, extra = D2 - base * n2; count = base + (j < extra ? 1 : 0); first = D1 + j * base + (j < extra ? j : extra); }
        pg8::Gemm g{(const bf16*)(F.ws + WS_HACT), (const bf16*)(F.ws + WS_WDN), 256};
        EpiDN E{F.ws, tab};
        pg8::MoeRangeOrder S{first, count, 4, tab, F.ctl + CW_READY, 16u};
        pg8::gemm_phase((PG8_LAS unsigned char*)F.lds, g, S, E, F.wave);
    }
}
DI void phase_final(Ctx& F) {
    float* H2 = F.out; const float* fg = INP(21); const int* tokinfo = (const int*)(F.ws + WS_TOKINFO);
    int* tb = (int*)(F.lds + LDS_MOETAB + 4096);
    if (F.wave == 0) { const int nte = ((int)F.ctl[CW_CNT + 64 * F.lane] + 255) >> 8; tb[F.lane] = (int)incl_scan((float)nte, F.lane) - nte; }
    __syncthreads();
    f32x4 gv[4];
#pragma unroll
    for (int j = 0; j < 4; ++j) gv[j] = ((const f32x4*)fg)[F.lane + 64 * j];
    for (int t = F.gw; t < NTOK; t += F.ngw) {
        const int i0 = tokinfo[4 * t], i1 = tokinfo[4 * t + 2]; const float w0 = __builtin_bit_cast(float, tokinfo[4 * t + 1]), w1 = __builtin_bit_cast(float, tokinfo[4 * t + 3]);
        const int h0 = tb[i0 >> 14] * 256 + (i0 & (MOE_CAP - 1)), h1 = tb[i1 >> 14] * 256 + (i1 & (MOE_CAP - 1));
        const bf16* ya = (const bf16*)(F.ws + ((h0 >> 8) < YA_SPLIT ? WS_YA_A + (size_t)h0 * 2048 : WS_YA_B + (size_t)(h0 - YA_SPLIT * 256) * 2048));
        const bf16* yb = (const bf16*)(F.ws + ((h1 >> 8) < YA_SPLIT ? WS_YA_A + (size_t)h1 * 2048 : WS_YA_B + (size_t)(h1 - YA_SPLIT * 256) * 2048));
        f32x4 v[4]; float ss = 0.f;
#pragma unroll
        for (int j = 0; j < 4; ++j) { v[j] = ((const f32x4*)(H2 + (size_t)t * 1024))[F.lane + 64 * j];
            const u32x2 a = ((const u32x2*)ya)[F.lane + 64 * j], c = ((const u32x2*)yb)[F.lane + 64 * j];
            v[j][0] += w0 * bflo(a.x) + w1 * bflo(c.x); v[j][1] += w0 * bfhi(a.x) + w1 * bfhi(c.x); v[j][2] += w0 * bflo(a.y) + w1 * bflo(c.y); v[j][3] += w0 * bfhi(a.y) + w1 * bfhi(c.y);
            ss += (v[j][0] * v[j][0] + v[j][1] * v[j][1]) + (v[j][2] * v[j][2] + v[j][3] * v[j][3]); }
        ss = wave_sum(ss); const float rs = __builtin_amdgcn_rsqf(ss * (1.0f / 1024.0f) + EPS);
        if (!F.dry) {
#pragma unroll
            for (int j = 0; j < 4; ++j) ((f32x4*)(H2 + (size_t)t * 1024))[F.lane + 64 * j] = v[j] * rs * gv[j]; }
    }
}

__global__ void __launch_bounds__(512, 2) mega_fwd(Args args) {
    extern __shared__ __attribute__((aligned(16))) unsigned char lds[];
    Ctx F;
    F.out = args.out; F.ws = args.ws; F.lds = lds; F.ctl = (unsigned*)(args.ws + WS_CTL);
    F.tid = threadIdx.x; F.lane = F.tid & 63; F.wave = __builtin_amdgcn_readfirstlane(F.tid >> 6);
    F.dry = false; F.G = gridDim.x; F.bid = blockIdx.x; F.vcu = (F.G % 8 == 0) ? (F.bid % 8) * (F.G / 8) + F.bid / 8 : F.bid; F.gw = F.vcu * 8 + F.wave; F.ngw = F.G * 8;
    const int lo = args.ph_lo, hi = args.ph_hi;
#if MK_LAUNCH_PER_PHASE
#define GRID_SYNC() do { } while (0)
#else
    volatile LAS unsigned* bst = (volatile LAS unsigned*)((LAS unsigned char*)lds + LDS_BARW);
    if (F.tid == 0) { bst[0] = 0u; bst[1] = 0u; }
    __syncthreads();
    const XcdBarrier gbar = xcd_barrier_post(F.ctl + CW_BAR, bst, F.tid == 0);
#define GRID_SYNC() xcd_barrier(gbar, F.wave == 0 && lane_id() == 0)
#endif
#ifndef MK_REPEAT
#define MK_REPEAT -1
#endif
#define REFRESH() do { F.lane = lane_id(); F.tid = F.wave * 64 + F.lane; } while (0)
#ifndef MK_DRY
#define MK_DRY -1
#endif
#if MK_DRY >= 0
    const unsigned zrt = F.ctl[CW_ZERO + 8];
#define DRYSET(v) F.dry = (v) ? (zrt == 0u) : (zrt != 0u)
#else
#define DRYSET(v) F.dry = false
#endif
#define PHASE(k, call) do { if (lo <= (k) && (k) < hi) { if ((k) == MK_REPEAT) { REFRESH(); call; GRID_SYNC(); } if ((k) == MK_DRY) { DRYSET(true); REFRESH(); call; GRID_SYNC(); } DRYSET(false); REFRESH(); call; if ((k) + 1 < hi) { GRID_SYNC(); } } } while (0)
    PHASE(0, phase_prep(F));
    PHASE(1, phase_inproj(F));
    PHASE(2, phase_dft_prep(F));
    PHASE(3, phase_scan(F));
    PHASE(4, phase_og_wexp(F));
    PHASE(5, phase_merge(F));
    PHASE(6, phase_outproj(F));
    PHASE(7, phase_router(F));
    PHASE(8, phase_experts(F));
    PHASE(9, phase_final(F));
#undef PHASE
}

extern "C" void kernel_launch(void* const* d_in, const int* in_sizes, int n_in, void* d_out, int out_size, void* d_ws, size_t ws_size, hipStream_t stream) {
    static int grid = 0;
    if (grid == 0) {
        int dev = 0, cus = 0, per_cu = 0;
        if (n_in != 22 || out_size != NTOK * DMOD || ws_size < WS_END) { fprintf(stderr, "kernel_launch: unexpected shapes (n_in %d out %d ws %zu need %zu)\n", n_in, out_size, ws_size, (size_t)WS_END); }
        hipGetDevice(&dev); hipDeviceGetAttribute(&cus, hipDeviceAttributeMultiprocessorCount, dev);
        hipFuncSetAttribute((const void*)mega_fwd, hipFuncAttributeMaxDynamicSharedMemorySize, LDS_BYTES);
        hipOccupancyMaxActiveBlocksPerMultiprocessor(&per_cu, (const void*)mega_fwd, 512, LDS_BYTES);
        if (per_cu < 1) { fprintf(stderr, "kernel_launch: occupancy query says %d blocks per CU\n", per_cu); per_cu = 1; }
        grid = cus;
        (void)hipGetLastError();
    }
    hipMemsetAsync((char*)d_ws + WS_CTL, 0, CTL_BYTES, stream);
    Args a{};
    for (int i = 0; i < 22; ++i) a.in[i] = (const float*)d_in[i];
    a.out = (float*)d_out; a.ws = (unsigned char*)d_ws;
#if MK_LAUNCH_PER_PHASE
    for (int p = 0; p < NPHASE; ++p) { a.ph_lo = p; a.ph_hi = p + 1; hipLaunchKernelGGL(mega_fwd, dim3(grid), dim3(512), LDS_BYTES, stream, a); }
#else
    a.ph_lo = 0; a.ph_hi = NPHASE;
    hipLaunchKernelGGL(mega_fwd, dim3(grid), dim3(512), LDS_BYTES, stream, a);
#endif
}
```

```cpp
#include <hip/hip_runtime.h>
#include <cstdio>

#ifndef MK_LAUNCH_PER_PHASE
#define MK_LAUNCH_PER_PHASE 0
#endif

#define DI __device__ __forceinline__
#define LAS __attribute__((address_space(3)))
typedef unsigned short bf16;
typedef short bf16x8 __attribute__((ext_vector_type(8)));
typedef float f32x4 __attribute__((ext_vector_type(4)));
typedef float f32x2 __attribute__((ext_vector_type(2)));
typedef unsigned u32x4 __attribute__((ext_vector_type(4)));
typedef unsigned u32x2 __attribute__((ext_vector_type(2)));

constexpr int NB = 8, SEQ = 2048, LTOK = 2064, DMOD = 1024, NTOK = NB * SEQ, NMETA = 16;
constexpr int NHEAD = 8, HDIM = 128;
constexpr int KP = 4224, KSIN = 2112;
constexpr int INW = 6688;
constexpr float EPS = 1e-6f;
constexpr int NPHASE = 10;

constexpr size_t MiB = 1u << 20;
constexpr size_t WS_CTL = 0, CTL_BYTES = 1 * MiB;
constexpr size_t WS_RSTD1 = 1 * MiB;
constexpr size_t WS_GB = 1 * MiB + 128 * 1024;
constexpr size_t WS_WF = 4 * MiB;
constexpr size_t WS_WD = 5 * MiB;
constexpr size_t WS_WO = 7 * MiB;
constexpr size_t WS_WR = 9 * MiB;
constexpr size_t WS_WAB = 9 * MiB + 512 * 1024;
constexpr size_t WS_RSTD2 = 9 * MiB + 640 * 1024;
constexpr size_t WS_GCUM = 9 * MiB + 768 * 1024;
constexpr size_t WS_ROUTE = 10 * MiB;
constexpr size_t WS_ROWINFO = 10 * MiB + 512 * 1024;
constexpr size_t WS_Z = 11 * MiB;
constexpr size_t WS_FM = 43 * MiB;
constexpr size_t WS_DM = 59 * MiB;
constexpr size_t WS_OF = 59 * MiB;
constexpr size_t WS_HALO = 76 * MiB;
constexpr size_t WS_XT = 90 * MiB;
constexpr size_t WS_OB = 91 * MiB;
constexpr size_t WS_QKVP = 123 * MiB;
constexpr size_t WS_XB = 220 * MiB;
constexpr size_t WS_WTIN = 253 * MiB;
constexpr size_t WS_TQK = 220 * MiB;
constexpr size_t WS_XN = 11 * MiB;
constexpr size_t WS_ROWTOK = 67 * MiB;
constexpr size_t WS_TOKINFO = 71 * MiB;
constexpr int MOE_CAP = 16384;
constexpr size_t WS_HACT = 43 * MiB;
constexpr size_t WS_WGU = 131 * MiB;
constexpr size_t WS_WDN = 195 * MiB;
constexpr size_t WS_YA_A = 72 * MiB, WS_YA_B = 227 * MiB;
constexpr int YA_SPLIT = 112;
constexpr size_t WS_END = 291 * MiB;
constexpr int CW_CNT = 8192;
constexpr int CW_BASE = 1152;
constexpr int CW_NTILES = 1280;
constexpr int CW_TILEE = 1536;
constexpr int CW_DNQ = 1472;
constexpr int CW_READY = 16384;
constexpr int CW_PREPQ = 1408;
constexpr int CW_ZERO = 131072;
constexpr int CW_BAR = 4096;
constexpr int LDS_BARW = 163328;
constexpr int LDS_MOETAB = 155648;

constexpr int LDS_BYTES = 163840;

DI int lane_id() { int l; asm volatile("v_mbcnt_lo_u32_b32 %0, -1, 0\n\tv_mbcnt_hi_u32_b32 %0, -1, %0" : "=v"(l)); return l; }
typedef __bf16 nbf16x2 __attribute__((ext_vector_type(2)));
DI unsigned f2bf(float f) { return (unsigned)__builtin_bit_cast(unsigned short, (__bf16)f); }
DI unsigned pk2(float lo, float hi) { nbf16x2 v = {(__bf16)lo, (__bf16)hi}; return __builtin_bit_cast(unsigned, v); }
DI float bf2f(unsigned b) { return __builtin_bit_cast(float, b << 16); }
DI float bflo(unsigned w) { return __builtin_bit_cast(float, w << 16); }
DI float bfhi(unsigned w) { return __builtin_bit_cast(float, w & 0xffff0000u); }
DI float wave_sum(float v) {
#pragma unroll
    for (int o = 1; o < 64; o <<= 1) v += __shfl_xor(v, o);
    return v;
}
DI void wave_sum8(float (&v)[8]) {
    const int lane = lane_id(); const bool h5 = (lane >> 5) & 1, h4 = (lane >> 4) & 1, h3 = (lane >> 3) & 1;
    float r[4], r2[2], r3;
#pragma unroll
    for (int j = 0; j < 4; ++j) { const float mine = h5 ? v[4 + j] : v[j], oth = h5 ? v[j] : v[4 + j]; r[j] = mine + __shfl_xor(oth, 32); }
#pragma unroll
    for (int j = 0; j < 2; ++j) { const float mine = h4 ? r[2 + j] : r[j], oth = h4 ? r[j] : r[2 + j]; r2[j] = mine + __shfl_xor(oth, 16); }
    { const float mine = h3 ? r2[1] : r2[0], oth = h3 ? r2[0] : r2[1]; r3 = mine + __shfl_xor(oth, 8); }
    r3 += __shfl_xor(r3, 4); r3 += __shfl_xor(r3, 2); r3 += __shfl_xor(r3, 1);
#pragma unroll
    for (int j = 0; j < 8; ++j) v[j] = __builtin_bit_cast(float, __builtin_amdgcn_readlane(__builtin_bit_cast(int, r3), 32 * (j >> 2) + 16 * ((j >> 1) & 1) + 8 * (j & 1)));
}
DI float sigm(float x) { return __builtin_amdgcn_rcpf(1.0f + __expf(-x)); }
DI float siluf(float x) { return x * sigm(x); }
DI float softplusf(float x) { return x > 20.f ? x : log1pf(__expf(x)); }
DI u32x4 pack8(f32x4 a, f32x4 b) { u32x4 w; w.x = pk2(a[0], a[1]); w.y = pk2(a[2], a[3]); w.z = pk2(b[0], b[1]); w.w = pk2(b[2], b[3]); return w; }
DI void unpack8(u32x4 w, f32x4& a, f32x4& b) { a[0] = bflo(w.x); a[1] = bfhi(w.x); a[2] = bflo(w.y); a[3] = bfhi(w.y); b[0] = bflo(w.z); b[1] = bfhi(w.z); b[2] = bflo(w.w); b[3] = bfhi(w.w); }
DI void st16(void* p, u32x4 v) { asm volatile("global_store_dwordx4 %0, %1, off sc1\n\ts_nop 1" :: "v"(p), "v"(v) : "memory"); }
#define LDS_WAIT() asm volatile("s_waitcnt lgkmcnt(0)" ::: "memory")
#define VM_WAIT() asm volatile("s_waitcnt vmcnt(0)" ::: "memory")


#define XB_TMO      128
#define XB_XCNT(j)  (256  + 64 * (j))
#define XB_XSUB(j)  (1280 + 64 * (j))
#define XB_XGEN(j)  (2304 + 64 * (j))
#define XB_TOP      3328
#define XB_TOPGEN   3392
#define XCD_BAR_WORDS 3456
#define XB_SPIN_CAP (1u << 22)
DI unsigned xb_ld(unsigned* p)              { return __hip_atomic_load(p, __ATOMIC_RELAXED, __HIP_MEMORY_SCOPE_AGENT); }
DI unsigned xb_add(unsigned* p, unsigned v) { return __hip_atomic_fetch_add(p, v, __ATOMIC_RELAXED, __HIP_MEMORY_SCOPE_AGENT); }
DI unsigned xb_xcc_id() { return (unsigned)__builtin_amdgcn_s_getreg((3 << 11) | 20) & 0xFu; }
#define XB_SPIN(cond, bar) do { unsigned _sp = 0; while (cond) { __builtin_amdgcn_s_sleep(1); \
    if ((++_sp & 255u) == 0u) { if (xb_ld(&(bar)[XB_TMO])) break; if (_sp > XB_SPIN_CAP) { atomicAdd(&(bar)[XB_TMO], 1u); break; } } } } while (0)
struct XcdBarrier { unsigned* bar; unsigned x; volatile LAS unsigned* st; };
DI XcdBarrier xcd_barrier_post(unsigned* bar, volatile LAS unsigned* st, bool leader) {
    XcdBarrier b; b.bar = bar; b.x = xb_xcc_id(); b.st = st;
    if (leader) (void)xb_add(&bar[XB_XCNT(b.x)], 1u);
    return b;
}
DI void xcd_barrier_complete(unsigned* bar, unsigned x, unsigned& nloc, unsigned& nx) {
    const unsigned G = gridDim.x * gridDim.y * gridDim.z;
    unsigned sum, cnt, mine, sp = 0u;
    for (;;) {
        sum = 0u; cnt = 0u; mine = 0u;
#pragma unroll
        for (unsigned j = 0; j < 16; ++j) { const unsigned c = xb_ld(&bar[XB_XCNT(j)]); sum += c; cnt += (c > 0u) ? 1u : 0u; mine = (j == x) ? c : mine; }
        if (sum == G) break;
        __builtin_amdgcn_s_sleep(1);
        if ((++sp & 255u) == 0u) { if (xb_ld(&bar[XB_TMO])) break; if (sp > XB_SPIN_CAP) { atomicAdd(&bar[XB_TMO], 1u); break; } }
    }
    nloc = mine > 0u ? mine : 1u; nx = cnt > 0u ? cnt : 1u;
}
DI void xcd_barrier(const XcdBarrier& b, bool leader) {
    asm volatile("s_waitcnt vmcnt(0)" ::: "memory");
    __syncthreads();
    if (leader) {
        unsigned* bar = b.bar;
        __builtin_amdgcn_s_waitcnt(0);
        unsigned nloc = b.st[0], nx = b.st[1];
        if (nloc == 0u) { xcd_barrier_complete(bar, b.x, nloc, nx); b.st[0] = nloc; b.st[1] = nx; }
        const unsigned old = xb_add(&bar[XB_XSUB(b.x)], 1u);
        const unsigned gen = old / nloc;
        if (old + 1u == (gen + 1u) * nloc) {
            __builtin_amdgcn_fence(__ATOMIC_RELEASE, "agent");
            asm volatile("s_waitcnt vmcnt(0)" ::: "memory");
            const unsigned og = xb_add(&bar[XB_TOP], 1u);
            const unsigned tg = og / nx;
            if (og + 1u == (tg + 1u) * nx) xb_add(&bar[XB_TOPGEN], 1u);
            else XB_SPIN(xb_ld(&bar[XB_TOPGEN]) == tg, bar);
            __builtin_amdgcn_fence(__ATOMIC_ACQUIRE, "agent");
            xb_add(&bar[XB_XGEN(b.x)], 1u);
            asm volatile("s_waitcnt vmcnt(0)" ::: "memory");
        } else {
            XB_SPIN(xb_ld(&bar[XB_XGEN(b.x)]) == gen, bar);
            __builtin_amdgcn_fence(__ATOMIC_ACQUIRE, "agent");
            asm volatile("s_waitcnt vmcnt(0)" ::: "memory");
        }
    }
    __syncthreads();
}

namespace pg8 {
#define PG8_LAS __attribute__((address_space(3)))
constexpr int BM = 256, BK = 64, HALF = 128, HTB = HALF * BK * 2, STAGE_BYTES = 8 * HTB, NXCD = 8, WGM = 8;
DI int lds_byte(int r, int c) { const int st = (r >> 4) * 2 + (c >> 5), rr = r & 15, cc = c & 31, ob = rr * 64 + cc * 2; return st * 1024 + (ob ^ (((ob >> 9) & 1) << 5)); }
DI void stage_rc(int b, int& R, int& C) { const int st = b / 1024, sb = b % 1024, swz = sb ^ (((sb >> 9) & 1) << 5); R = (st >> 1) * 16 + swz / 64; C = (st & 1) * 32 + (swz % 64) / 2; }
DI int perm32(int rho) { const int n = rho >> 4, i = rho & 15; return 8 * (i >> 2) + 4 * n + (i & 3); }

struct Unit { int pm, pn, aux; };
struct Gemm { const bf16* A; const bf16* Bt; int K; };

struct StaticOrder {
    static constexpr bool WAITS = false;
    int nM, nN, nwg, G, c;
    DI void init(int M, int N, int G_, int c_) { nM = M / BM; nN = N / BM; nwg = nM * nN; G = G_; c = c_; }
    DI bool next(int i, Unit& u) const {
        const long L = (long)i * G + c; if (L >= nwg) return false;
        int wgid = (int)L; { const int q = nwg / NXCD, r = nwg % NXCD, xcd = wgid % NXCD, off = wgid / NXCD; wgid = (xcd < r ? xcd * (q + 1) : r * (q + 1) + (xcd - r) * q) + off; }
        const int nig = WGM * nN, gid = wgid / nig, fm = gid * WGM, gsz = (nM - fm) < WGM ? (nM - fm) : WGM;
        u.pm = fm + ((wgid % nig) % gsz); u.pn = (wgid % nig) / gsz; u.aux = 0; return true;
    }
    DI int arow(const Unit& u) const { return u.pm; }
    DI int brow(const Unit& u) const { return u.pn; }
};
struct DftOrder {
    static constexpr bool WAITS = false;
    int G, c;
    DI bool next(int i, Unit& u) const { const int L = i * G + c; if (L >= 128) return false; u.pm = L >> 1; u.pn = L & 1; u.aux = 0; return true; }
    DI int arow(const Unit& u) const { return u.pm & 7; }
    DI int brow(const Unit& u) const { return (u.pm >> 3) * 2 + u.pn; }
};
struct MoeOrder {
    static constexpr bool WAITS = false;
    int count, nN, G, c; const PG8_LAS int* tab; unsigned* ready;
    DI bool next(int i, Unit& u) const { const int L = i * G + c; if (L >= count) return false; u.pm = L / nN; u.pn = L - u.pm * nN; u.aux = tab[u.pm]; return true; }
    DI int arow(const Unit& u) const { return u.pm; }
    DI int brow(const Unit& u) const { return u.aux * nN + u.pn; }
    DI int rowbase(const Unit& u) const { return tab[256 + u.pm]; }
    DI int nvalid(const Unit& u) const { return tab[512 + u.pm]; }
    DI void done(const Unit& u, int lane) const { asm volatile("s_waitcnt vmcnt(0)" ::: "memory"); if (lane == 0) __hip_atomic_fetch_add(ready + 64 * u.pm, 1u, __ATOMIC_RELAXED, __HIP_MEMORY_SCOPE_AGENT); }
};
struct MoeRangeOrder {
    static constexpr bool WAITS = true;
    int first, count, nN; const PG8_LAS int* tab; unsigned* ready; unsigned need;
    DI bool next(int i, Unit& u) const { if (i >= count) return false; const int L = first + i; u.pm = L / nN; u.pn = L - u.pm * nN; u.aux = tab[u.pm]; return true; }
    DI int arow(const Unit& u) const { return u.pm; }
    DI int brow(const Unit& u) const { return u.aux * nN + u.pn; }
    DI void a_ready(const Unit& u, int wid) const {
        if (wid == 0) { unsigned sp = 0;
            while ((unsigned)__builtin_amdgcn_readfirstlane((int)__hip_atomic_load(ready + 64 * u.pm, __ATOMIC_RELAXED, __HIP_MEMORY_SCOPE_AGENT)) < need) { __builtin_amdgcn_s_sleep(2); if (++sp > (1u << 22)) break; }
            __builtin_amdgcn_fence(__ATOMIC_ACQUIRE, "agent"); asm volatile("s_waitcnt vmcnt(0)" ::: "memory"); }
        asm volatile("" ::: "memory"); __builtin_amdgcn_s_barrier(); asm volatile("" ::: "memory");
    }
};

template <class Epi, class Sched>
DI void gemm_phase(PG8_LAS unsigned char* lds, const Gemm g, const Sched& S, const Epi& E, int wave_id) {
    const int wid = wave_id, lane = lane_id(), tid = wid * 64 + lane, wr = wid >> 2, wc = wid & 3, fr = lane & 15, fq = lane >> 4;
    const int K = g.K, nt = K / BK;
    unsigned voffA[2], voffB[2];
#pragma unroll
    for (int i = 0; i < 2; ++i) { int R, C; stage_rc(tid * 16 + i * 8192, R, C); const int Rb = Epi::PERM ? ((R & ~31) + perm32(R & 31)) : R;
        voffA[i] = (unsigned)(R * K + C) * 2u; voffB[i] = (unsigned)(Rb * K + C) * 2u; }
    const size_t kstep = (size_t)(BK * 2);
    const size_t hstep = (size_t)HALF * K * 2;
    const size_t tstep = 2 * hstep;
    const unsigned ldsw = (unsigned)wid * 1024u;
    const int aoff = lds_byte(wr * 64 + fr, fq * 8), boff = lds_byte(wc * 32 + fr, fq * 8);
#define PG8_SA(b, h) (((b) * 2 + (h)) * HTB)
#define PG8_SB(b, h) ((4 + (b) * 2 + (h)) * HTB)
#define PG8_STAGE(bufoff, gbase, voff) do { _Pragma("unroll") for (int _i = 0; _i < 2; ++_i) \
        __builtin_amdgcn_global_load_lds((const unsigned*)((const char*)(gbase) + (voff)[_i]), (PG8_LAS unsigned*)(lds + (bufoff) + ldsw + _i * 8192), 16, 0, 0); } while (0)
#define PG8_LDA(dst, b, h) do { _Pragma("unroll") for (int m = 0; m < 4; ++m) _Pragma("unroll") for (int k = 0; k < 2; ++k) dst[m][k] = *(const PG8_LAS bf16x8*)(lds + PG8_SA(b, h) + aoff + m * 2048 + k * 1024); } while (0)
#define PG8_LDB(dst, b, h) do { _Pragma("unroll") for (int n = 0; n < 2; ++n) _Pragma("unroll") for (int k = 0; k < 2; ++k) dst[n][k] = *(const PG8_LAS bf16x8*)(lds + PG8_SB(b, h) + boff + n * 2048 + k * 1024); } while (0)
#define PG8_MMA(ai, bj, At, Bt) do { __builtin_amdgcn_s_setprio(1); _Pragma("unroll") for (int m = 0; m < 4; ++m) _Pragma("unroll") for (int n = 0; n < 2; ++n) _Pragma("unroll") for (int k = 0; k < 2; ++k) \
        acc[ai][bj][m][n] = __builtin_amdgcn_mfma_f32_16x16x32_bf16(Bt[n][k], At[m][k], acc[ai][bj][m][n], 0, 0, 0); __builtin_amdgcn_s_setprio(0); } while (0)
#define PG8_WAIT_V(n) asm volatile("s_waitcnt vmcnt(" #n ")" ::: "memory")
#define PG8_WAIT_L(n) asm volatile("s_waitcnt lgkmcnt(" #n ")" ::: "memory")
#define PG8_BAR __builtin_amdgcn_s_barrier()
#define PG8_SCHED __builtin_amdgcn_sched_barrier(0)
    Unit cur, nxt; int ui = 0;
    if (!S.next(0, cur)) return;
    f32x4 acc[2][2][4][2];
#pragma unroll
    for (int a = 0; a < 2; ++a)
#pragma unroll
        for (int b = 0; b < 2; ++b)
#pragma unroll
            for (int m = 0; m < 4; ++m)
#pragma unroll
                for (int n = 0; n < 2; ++n) acc[a][b][m][n] = (f32x4){0.f, 0.f, 0.f, 0.f};
    bf16x8 At[4][2], B0[2][2], B1[2][2];
    const char* cA = (const char*)g.A + (size_t)S.arow(cur) * tstep; const char* cB = (const char*)g.Bt + (size_t)S.brow(cur) * tstep;
    if constexpr (Sched::WAITS) S.a_ready(cur, wid);
    PG8_STAGE(PG8_SB(0, 0), cB, voffB); PG8_STAGE(PG8_SA(0, 0), cA, voffA); PG8_STAGE(PG8_SB(0, 1), cB + hstep, voffB); PG8_STAGE(PG8_SA(0, 1), cA + hstep, voffA);
    if (wr == 1) PG8_BAR;
    PG8_WAIT_V(4); PG8_BAR;
    PG8_STAGE(PG8_SB(1, 0), cB + kstep, voffB); PG8_STAGE(PG8_SA(1, 0), cA + kstep, voffA); PG8_STAGE(PG8_SB(1, 1), cB + hstep + kstep, voffB);
    PG8_WAIT_V(6); PG8_BAR;
    for (;;) {
        const bool has_next = S.next(ui + 1, nxt);
        const char* nA = has_next ? (const char*)g.A + (size_t)S.arow(nxt) * tstep : cA; const char* nB = has_next ? (const char*)g.Bt + (size_t)S.brow(nxt) * tstep : cB;
        for (int t = 0; t < nt; t += 2) {
            const bool last = (t == nt - 2);
            const char* a1 = cA + (size_t)(t + 1) * kstep;
            const char* a2 = last ? nA : cA + (size_t)(t + 2) * kstep; const char* b2 = last ? nB : cB + (size_t)(t + 2) * kstep;
            const char* a3 = a2 + kstep; const char* b3 = b2 + kstep;
            if constexpr (Sched::WAITS) { if (last && has_next) S.a_ready(nxt, wid); }
            PG8_LDB(B0, 0, 0); PG8_SCHED; PG8_LDA(At, 0, 0); PG8_STAGE(PG8_SA(1, 1), a1 + hstep, voffA);
            PG8_WAIT_L(8); PG8_BAR; PG8_WAIT_L(0); PG8_MMA(0, 0, At, B0); PG8_BAR; PG8_SCHED;
            PG8_LDB(B1, 0, 1); PG8_STAGE(PG8_SB(0, 0), b2, voffB);
            PG8_BAR; PG8_WAIT_L(0); PG8_MMA(0, 1, At, B1); PG8_BAR;
            PG8_LDA(At, 0, 1); PG8_STAGE(PG8_SA(0, 0), a2, voffA);
            PG8_BAR; PG8_WAIT_L(0); PG8_MMA(1, 0, At, B0); PG8_BAR; PG8_SCHED;
            PG8_STAGE(PG8_SB(0, 1), b2 + hstep, voffB);
            PG8_WAIT_V(6); PG8_BAR; PG8_MMA(1, 1, At, B1); PG8_BAR;
            PG8_LDB(B0, 1, 0); PG8_SCHED; PG8_LDA(At, 1, 0); PG8_STAGE(PG8_SA(0, 1), a2 + hstep, voffA);
            PG8_WAIT_L(8); PG8_BAR; PG8_WAIT_L(0); PG8_MMA(0, 0, At, B0); PG8_BAR; PG8_SCHED;
            PG8_LDB(B1, 1, 1); PG8_STAGE(PG8_SB(1, 0), b3, voffB);
            PG8_BAR; PG8_WAIT_L(0); PG8_MMA(0, 1, At, B1); PG8_BAR;
            PG8_LDA(At, 1, 1); PG8_STAGE(PG8_SA(1, 0), a3, voffA);
            PG8_BAR; PG8_WAIT_L(0); PG8_MMA(1, 0, At, B0); PG8_BAR; PG8_SCHED;
            PG8_STAGE(PG8_SB(1, 1), b3 + hstep, voffB);
            PG8_WAIT_V(6); PG8_BAR; PG8_MMA(1, 1, At, B1); PG8_BAR;
        }
        { const int ln = lane_id(); E(acc, cur, wr, wc, ln & 15, ln >> 4); }
        if (!has_next) break;
#pragma unroll
        for (int a = 0; a < 2; ++a)
#pragma unroll
            for (int b = 0; b < 2; ++b)
#pragma unroll
                for (int m = 0; m < 4; ++m)
#pragma unroll
                    for (int n = 0; n < 2; ++n) acc[a][b][m][n] = (f32x4){0.f, 0.f, 0.f, 0.f};
        cur = nxt; cA = nA; cB = nB; ++ui;
    }
    PG8_WAIT_V(0);
    if (wr == 0) PG8_BAR;
    PG8_BAR;
#undef PG8_SA
#undef PG8_SB
#undef PG8_STAGE
#undef PG8_LDA
#undef PG8_LDB
#undef PG8_MMA
#undef PG8_WAIT_V
#undef PG8_WAIT_L
#undef PG8_BAR
#undef PG8_SCHED
}

struct Gemm2 { const bf16* A1; int K1; const bf16* A2; int K2; const bf16* Bt; };
template <class Epi, class Sched>
DI void gemm_phase_dual(PG8_LAS unsigned char* lds, const Gemm2 g, const Sched& S, const Epi& E, int wave_id) {
    const int wid = wave_id, lane = lane_id(), tid = wid * 64 + lane, wr = wid >> 2, wc = wid & 3, fr = lane & 15, fq = lane >> 4;
    const int K1 = g.K1, K2 = g.K2, K = K1 + K2, nt = K / BK, k1t = K1 / BK;
    unsigned voffA1[2], voffA2[2], voffB[2];
#pragma unroll
    for (int i = 0; i < 2; ++i) { int R, C; stage_rc(tid * 16 + i * 8192, R, C); const int Rb = Epi::PERM ? ((R & ~31) + perm32(R & 31)) : R;
        voffA1[i] = (unsigned)(R * K1 + C) * 2u; voffA2[i] = (unsigned)(R * K2 + C) * 2u; voffB[i] = (unsigned)(Rb * K + C) * 2u; }
    const size_t kstep = (size_t)(BK * 2);
    const size_t hA1 = (size_t)HALF * K1 * 2, hA2 = (size_t)HALF * K2 * 2, hB = (size_t)HALF * K * 2;
    const unsigned ldsw = (unsigned)wid * 1024u;
    const int aoff = lds_byte(wr * 64 + fr, fq * 8), boff = lds_byte(wc * 32 + fr, fq * 8);
#define PG8_SA(b, h) (((b) * 2 + (h)) * HTB)
#define PG8_SB(b, h) ((4 + (b) * 2 + (h)) * HTB)
#define PG8_STAGE(bufoff, gbase, voff) do { _Pragma("unroll") for (int _i = 0; _i < 2; ++_i) \
        __builtin_amdgcn_global_load_lds((const unsigned*)((const char*)(gbase) + (voff)[_i]), (PG8_LAS unsigned*)(lds + (bufoff) + ldsw + _i * 8192), 16, 0, 0); } while (0)
#define PG8_STAGE_A(bufoff, h, kt, b1, b2) do { const bool _s1 = (kt) < k1t; const char* _p = _s1 ? (b1) + (size_t)(h) * hA1 + (size_t)(kt) * kstep : (b2) + (size_t)(h) * hA2 + (size_t)((kt) - k1t) * kstep; \
        unsigned _v[2]; _v[0] = _s1 ? voffA1[0] : voffA2[0]; _v[1] = _s1 ? voffA1[1] : voffA2[1]; PG8_STAGE(bufoff, _p, _v); } while (0)
#define PG8_LDA(dst, b, h) do { _Pragma("unroll") for (int m = 0; m < 4; ++m) _Pragma("unroll") for (int k = 0; k < 2; ++k) dst[m][k] = *(const PG8_LAS bf16x8*)(lds + PG8_SA(b, h) + aoff + m * 2048 + k * 1024); } while (0)
#define PG8_LDB(dst, b, h) do { _Pragma("unroll") for (int n = 0; n < 2; ++n) _Pragma("unroll") for (int k = 0; k < 2; ++k) dst[n][k] = *(const PG8_LAS bf16x8*)(lds + PG8_SB(b, h) + boff + n * 2048 + k * 1024); } while (0)
#define PG8_MMA(ai, bj, At, Bt) do { __builtin_amdgcn_s_setprio(1); _Pragma("unroll") for (int m = 0; m < 4; ++m) _Pragma("unroll") for (int n = 0; n < 2; ++n) _Pragma("unroll") for (int k = 0; k < 2; ++k) \
        acc[ai][bj][m][n] = __builtin_amdgcn_mfma_f32_16x16x32_bf16(Bt[n][k], At[m][k], acc[ai][bj][m][n], 0, 0, 0); __builtin_amdgcn_s_setprio(0); } while (0)
#define PG8_WAIT_V(n) asm volatile("s_waitcnt vmcnt(" #n ")" ::: "memory")
#define PG8_WAIT_L(n) asm volatile("s_waitcnt lgkmcnt(" #n ")" ::: "memory")
#define PG8_BAR __builtin_amdgcn_s_barrier()
#define PG8_SCHED __builtin_amdgcn_sched_barrier(0)
    Unit cur, nxt; int ui = 0;
    if (!S.next(0, cur)) return;
    f32x4 acc[2][2][4][2];
#pragma unroll
    for (int a = 0; a < 2; ++a)
#pragma unroll
        for (int b = 0; b < 2; ++b)
#pragma unroll
            for (int m = 0; m < 4; ++m)
#pragma unroll
                for (int n = 0; n < 2; ++n) acc[a][b][m][n] = (f32x4){0.f, 0.f, 0.f, 0.f};
    bf16x8 At[4][2], B0[2][2], B1[2][2];
    const char* c1 = (const char*)g.A1 + (size_t)S.arow(cur) * 2 * hA1; const char* c2 = (const char*)g.A2 + (size_t)S.arow(cur) * 2 * hA2; const char* cB = (const char*)g.Bt + (size_t)S.brow(cur) * 2 * hB;
    PG8_STAGE(PG8_SB(0, 0), cB, voffB); PG8_STAGE_A(PG8_SA(0, 0), 0, 0, c1, c2); PG8_STAGE(PG8_SB(0, 1), cB + hB, voffB); PG8_STAGE_A(PG8_SA(0, 1), 1, 0, c1, c2);
    if (wr == 1) PG8_BAR;
    PG8_WAIT_V(4); PG8_BAR;
    PG8_STAGE(PG8_SB(1, 0), cB + kstep, voffB); PG8_STAGE_A(PG8_SA(1, 0), 0, 1, c1, c2); PG8_STAGE(PG8_SB(1, 1), cB + hB + kstep, voffB);
    PG8_WAIT_V(6); PG8_BAR;
    for (;;) {
        const bool has_next = S.next(ui + 1, nxt);
        const char* n1 = has_next ? (const char*)g.A1 + (size_t)S.arow(nxt) * 2 * hA1 : c1; const char* n2 = has_next ? (const char*)g.A2 + (size_t)S.arow(nxt) * 2 * hA2 : c2;
        const char* nB = has_next ? (const char*)g.Bt + (size_t)S.brow(nxt) * 2 * hB : cB;
        for (int t = 0; t < nt; t += 2) {
            const bool last = (t == nt - 2);
            if (t == k1t) { const int ln = lane_id(); E.mid(acc, cur, wr, wc, ln & 15, ln >> 4); }
            const int kt2 = last ? 0 : t + 2, kt3 = kt2 + 1; const char* q1 = last ? n1 : c1; const char* q2 = last ? n2 : c2;
            const char* b2 = last ? nB : cB + (size_t)(t + 2) * kstep; const char* b3 = b2 + kstep;
            PG8_LDB(B0, 0, 0); PG8_SCHED; PG8_LDA(At, 0, 0); PG8_STAGE_A(PG8_SA(1, 1), 1, t + 1, c1, c2);
            PG8_WAIT_L(8); PG8_BAR; PG8_WAIT_L(0); PG8_MMA(0, 0, At, B0); PG8_BAR; PG8_SCHED;
            PG8_LDB(B1, 0, 1); PG8_STAGE(PG8_SB(0, 0), b2, voffB);
            PG8_BAR; PG8_WAIT_L(0); PG8_MMA(0, 1, At, B1); PG8_BAR;
            PG8_LDA(At, 0, 1); PG8_STAGE_A(PG8_SA(0, 0), 0, kt2, q1, q2);
            PG8_BAR; PG8_WAIT_L(0); PG8_MMA(1, 0, At, B0); PG8_BAR; PG8_SCHED;
            PG8_STAGE(PG8_SB(0, 1), b2 + hB, voffB);
            PG8_WAIT_V(6); PG8_BAR; PG8_MMA(1, 1, At, B1); PG8_BAR;
            PG8_LDB(B0, 1, 0); PG8_SCHED; PG8_LDA(At, 1, 0); PG8_STAGE_A(PG8_SA(0, 1), 1, kt2, q1, q2);
            PG8_WAIT_L(8); PG8_BAR; PG8_WAIT_L(0); PG8_MMA(0, 0, At, B0); PG8_BAR; PG8_SCHED;
            PG8_LDB(B1, 1, 1); PG8_STAGE(PG8_SB(1, 0), b3, voffB);
            PG8_BAR; PG8_WAIT_L(0); PG8_MMA(0, 1, At, B1); PG8_BAR;
            PG8_LDA(At, 1, 1); PG8_STAGE_A(PG8_SA(1, 0), 0, kt3, q1, q2);
            PG8_BAR; PG8_WAIT_L(0); PG8_MMA(1, 0, At, B0); PG8_BAR; PG8_SCHED;
            PG8_STAGE(PG8_SB(1, 1), b3 + hB, voffB);
            PG8_WAIT_V(6); PG8_BAR; PG8_MMA(1, 1, At, B1); PG8_BAR;
        }
        { const int ln = lane_id(); E(acc, cur, wr, wc, ln & 15, ln >> 4); }
        if (!has_next) break;
#pragma unroll
        for (int a = 0; a < 2; ++a)
#pragma unroll
            for (int b = 0; b < 2; ++b)
#pragma unroll
                for (int m = 0; m < 4; ++m)
#pragma unroll
                    for (int n = 0; n < 2; ++n) acc[a][b][m][n] = (f32x4){0.f, 0.f, 0.f, 0.f};
        cur = nxt; c1 = n1; c2 = n2; cB = nB; ++ui;
    }
    PG8_WAIT_V(0);
    if (wr == 0) PG8_BAR;
    PG8_BAR;
#undef PG8_SA
#undef PG8_SB
#undef PG8_STAGE
#undef PG8_STAGE_A
#undef PG8_LDA
#undef PG8_LDB
#undef PG8_MMA
#undef PG8_WAIT_V
#undef PG8_WAIT_L
#undef PG8_BAR
#undef PG8_SCHED
}

template <class Epi, class Sched>
DI void gemm_phase_gather(PG8_LAS unsigned char* lds, const Gemm g, const int* rowtok, const Sched& S, const Epi& E, int wave_id) {
    const int wid = wave_id, lane = lane_id(), tid = wid * 64 + lane, wr = wid >> 2, wc = wid & 3, fr = lane & 15, fq = lane >> 4;
    const int K = g.K, nt = K / BK;
    unsigned voffB[2]; int Rr[2], Cc[2];
#pragma unroll
    for (int i = 0; i < 2; ++i) { int R, C; stage_rc(tid * 16 + i * 8192, R, C); const int Rb = Epi::PERM ? ((R & ~31) + perm32(R & 31)) : R;
        Rr[i] = R; Cc[i] = C; voffB[i] = (unsigned)(Rb * K + C) * 2u; }
    const size_t kstep = (size_t)(BK * 2);
    const size_t hstep = (size_t)HALF * K * 2;
    const size_t tstep = 2 * hstep;
    const unsigned ldsw = (unsigned)wid * 1024u;
    const int aoff = lds_byte(wr * 64 + fr, fq * 8), boff = lds_byte(wc * 32 + fr, fq * 8);
#define PG8_SA(b, h) (((b) * 2 + (h)) * HTB)
#define PG8_SB(b, h) ((4 + (b) * 2 + (h)) * HTB)
#define PG8_STAGE(bufoff, gbase, voff) do { _Pragma("unroll") for (int _i = 0; _i < 2; ++_i) \
        __builtin_amdgcn_global_load_lds((const unsigned*)((const char*)(gbase) + (voff)[_i]), (PG8_LAS unsigned*)(lds + (bufoff) + ldsw + _i * 8192), 16, 0, 0); } while (0)
#define PG8_GOFF(u, dst) do { const int _nv = S.nvalid(u), _rb = S.rowbase(u); _Pragma("unroll") for (int _h = 0; _h < 2; ++_h) _Pragma("unroll") for (int _i = 0; _i < 2; ++_i) { \
        const int _R = Rr[_i] + 128 * _h; const int _t = _R < _nv ? rowtok[_rb + _R] : 0; dst[_h][_i] = (unsigned)(_t * K + Cc[_i]) * 2u; } } while (0)
#define PG8_LDA(dst, b, h) do { _Pragma("unroll") for (int m = 0; m < 4; ++m) _Pragma("unroll") for (int k = 0; k < 2; ++k) dst[m][k] = *(const PG8_LAS bf16x8*)(lds + PG8_SA(b, h) + aoff + m * 2048 + k * 1024); } while (0)
#define PG8_LDB(dst, b, h) do { _Pragma("unroll") for (int n = 0; n < 2; ++n) _Pragma("unroll") for (int k = 0; k < 2; ++k) dst[n][k] = *(const PG8_LAS bf16x8*)(lds + PG8_SB(b, h) + boff + n * 2048 + k * 1024); } while (0)
#define PG8_MMA(ai, bj, At, Bt) do { __builtin_amdgcn_s_setprio(1); _Pragma("unroll") for (int m = 0; m < 4; ++m) _Pragma("unroll") for (int n = 0; n < 2; ++n) _Pragma("unroll") for (int k = 0; k < 2; ++k) \
        acc[ai][bj][m][n] = __builtin_amdgcn_mfma_f32_16x16x32_bf16(Bt[n][k], At[m][k], acc[ai][bj][m][n], 0, 0, 0); __builtin_amdgcn_s_setprio(0); } while (0)
#define PG8_WAIT_V(n) asm volatile("s_waitcnt vmcnt(" #n ")" ::: "memory")
#define PG8_WAIT_L(n) asm volatile("s_waitcnt lgkmcnt(" #n ")" ::: "memory")
#define PG8_BAR __builtin_amdgcn_s_barrier()
#define PG8_SCHED __builtin_amdgcn_sched_barrier(0)
    Unit cur, nxt; int ui = 0;
    if (!S.next(0, cur)) return;
    f32x4 acc[2][2][4][2];
#pragma unroll
    for (int a = 0; a < 2; ++a)
#pragma unroll
        for (int b = 0; b < 2; ++b)
#pragma unroll
            for (int m = 0; m < 4; ++m)
#pragma unroll
                for (int n = 0; n < 2; ++n) acc[a][b][m][n] = (f32x4){0.f, 0.f, 0.f, 0.f};
    bf16x8 At[4][2], B0[2][2], B1[2][2];
    unsigned gA[2][2], gN[2][2];
    PG8_GOFF(cur, gA);
    const char* Ab = (const char*)g.A; const char* cB = (const char*)g.Bt + (size_t)S.brow(cur) * tstep;
    PG8_STAGE(PG8_SB(0, 0), cB, voffB); PG8_STAGE(PG8_SA(0, 0), Ab, gA[0]); PG8_STAGE(PG8_SB(0, 1), cB + hstep, voffB); PG8_STAGE(PG8_SA(0, 1), Ab, gA[1]);
    if (wr == 1) PG8_BAR;
    PG8_WAIT_V(4); PG8_BAR;
    PG8_STAGE(PG8_SB(1, 0), cB + kstep, voffB); PG8_STAGE(PG8_SA(1, 0), Ab + kstep, gA[0]); PG8_STAGE(PG8_SB(1, 1), cB + hstep + kstep, voffB);
    PG8_WAIT_V(6); PG8_BAR;
    for (;;) {
        const bool has_next = S.next(ui + 1, nxt);
        if (has_next) PG8_GOFF(nxt, gN); else {
#pragma unroll
            for (int h = 0; h < 2; ++h)
#pragma unroll
                for (int i = 0; i < 2; ++i) gN[h][i] = gA[h][i]; }
        const char* nB = has_next ? (const char*)g.Bt + (size_t)S.brow(nxt) * tstep : cB;
        for (int t = 0; t < nt; t += 2) {
            const bool last = (t == nt - 2);
            const char* a1 = Ab + (size_t)(t + 1) * kstep;
            const char* a2 = last ? Ab : Ab + (size_t)(t + 2) * kstep; const char* b2 = last ? nB : cB + (size_t)(t + 2) * kstep;
            const char* a3 = a2 + kstep; const char* b3 = b2 + kstep;
            unsigned g2[2][2];
#pragma unroll
            for (int h = 0; h < 2; ++h)
#pragma unroll
                for (int i = 0; i < 2; ++i) g2[h][i] = last ? gN[h][i] : gA[h][i];
            PG8_LDB(B0, 0, 0); PG8_SCHED; PG8_LDA(At, 0, 0); PG8_STAGE(PG8_SA(1, 1), a1, gA[1]);
            PG8_WAIT_L(8); PG8_BAR; PG8_WAIT_L(0); PG8_MMA(0, 0, At, B0); PG8_BAR; PG8_SCHED;
            PG8_LDB(B1, 0, 1); PG8_STAGE(PG8_SB(0, 0), b2, voffB);
            PG8_BAR; PG8_WAIT_L(0); PG8_MMA(0, 1, At, B1); PG8_BAR;
            PG8_LDA(At, 0, 1); PG8_STAGE(PG8_SA(0, 0), a2, g2[0]);
            PG8_BAR; PG8_WAIT_L(0); PG8_MMA(1, 0, At, B0); PG8_BAR; PG8_SCHED;
            PG8_STAGE(PG8_SB(0, 1), b2 + hstep, voffB);
            PG8_WAIT_V(6); PG8_BAR; PG8_MMA(1, 1, At, B1); PG8_BAR;
            PG8_LDB(B0, 1, 0); PG8_SCHED; PG8_LDA(At, 1, 0); PG8_STAGE(PG8_SA(0, 1), a2, g2[1]);
            PG8_WAIT_L(8); PG8_BAR; PG8_WAIT_L(0); PG8_MMA(0, 0, At, B0); PG8_BAR; PG8_SCHED;
            PG8_LDB(B1, 1, 1); PG8_STAGE(PG8_SB(1, 0), b3, voffB);
            PG8_BAR; PG8_WAIT_L(0); PG8_MMA(0, 1, At, B1); PG8_BAR;
            PG8_LDA(At, 1, 1); PG8_STAGE(PG8_SA(1, 0), a3, g2[0]);
            PG8_BAR; PG8_WAIT_L(0); PG8_MMA(1, 0, At, B0); PG8_BAR; PG8_SCHED;
            PG8_STAGE(PG8_SB(1, 1), b3 + hstep, voffB);
            PG8_WAIT_V(6); PG8_BAR; PG8_MMA(1, 1, At, B1); PG8_BAR;
        }
        { const int ln = lane_id(); E(acc, cur, wr, wc, ln & 15, ln >> 4); S.done(cur, ln); }
        if (!has_next) break;
#pragma unroll
        for (int a = 0; a < 2; ++a)
#pragma unroll
            for (int b = 0; b < 2; ++b)
#pragma unroll
                for (int m = 0; m < 4; ++m)
#pragma unroll
                    for (int n = 0; n < 2; ++n) acc[a][b][m][n] = (f32x4){0.f, 0.f, 0.f, 0.f};
#pragma unroll
        for (int h = 0; h < 2; ++h)
#pragma unroll
            for (int i = 0; i < 2; ++i) gA[h][i] = gN[h][i];
        cur = nxt; cB = nB; ++ui;
    }
    PG8_WAIT_V(0);
    if (wr == 0) PG8_BAR;
    PG8_BAR;
#undef PG8_SA
#undef PG8_SB
#undef PG8_STAGE
#undef PG8_GOFF
#undef PG8_LDA
#undef PG8_LDB
#undef PG8_MMA
#undef PG8_WAIT_V
#undef PG8_WAIT_L
#undef PG8_BAR
#undef PG8_SCHED
}
}
using pg8::Unit;
typedef f32x4 AccT[2][2][4][2];

struct EpiXT {
    static constexpr bool PERM = true;
    bf16* XT; const float* rstd;
    DI void operator()(const AccT& acc, const Unit& u, int wr, int wc, int fr, int fq) const {
#pragma unroll
        for (int bj = 0; bj < 2; ++bj) {
            const int t0 = u.pn * 256 + bj * 128 + wc * 32 + 8 * fq, b = t0 >> 11, l0 = 16 + (t0 & 2047);

#pragma unroll
            for (int ai = 0; ai < 2; ++ai)
#pragma unroll
                for (int m = 0; m < 4; ++m) {
                    const int np = u.pm * 256 + ai * 128 + wr * 64 + m * 16 + fr;
                    bf16* dst = XT + ((size_t)(b * 512 + (np & 511)) * KP + (np >= 512 ? KSIN : 0) + l0);
                    *(u32x4*)dst = pack8(acc[ai][bj][m][0], acc[ai][bj][m][1]);
                }
        }
    }
};
struct EpiIn {
    static constexpr bool PERM = true;
    bf16 *QKVP, *Z, *GF, *GD; const float* rstd; bf16* HALO;
    DI void operator()(const AccT& acc, const Unit& u, int wr, int wc, int fr, int fq) const {
        const int seg = u.pn < 12 ? 0 : (u.pn < 16 ? 1 : (u.pn < 20 ? 2 : 3));
#pragma unroll
        for (int ai = 0; ai < 2; ++ai)
#pragma unroll
            for (int m = 0; m < 4; ++m) {
                const int t = u.pm * 256 + ai * 128 + wr * 64 + m * 16 + fr;
#pragma unroll
                for (int bj = 0; bj < 2; ++bj) {
                    const int n = u.pn * 256 + bj * 128 + wc * 32 + 8 * fq;
                    f32x4 v0 = acc[ai][bj][m][0], v1 = acc[ai][bj][m][1]; bf16* dst;
                    if (seg == 0) { dst = QKVP + ((size_t)((t >> 11) * LTOK + 16 + (t & 2047)) * 3072 + n);
                        const int sq = t & 2047, ii = sq & 63; int hc = -1, hr = 0;
                        if (ii >= 62) { hc = (sq >> 6) + 1; hr = ii - 62; } else if (ii <= 1) { hc = sq >> 6; hr = 2 + ii; }
                        if (hc >= 0 && hc < 32) *(u32x4*)(HALO + ((size_t)(((t >> 11) * 32 + hc) * 4 + hr) * 3072 + n)) = pack8(v0, v1); }
                    else if (seg == 1) { dst = Z + (size_t)t * 1024 + (n - 3072); }
                    else {
                        unsigned char* gdst = (unsigned char*)(seg == 2 ? GF : GD) + ((size_t)((((((u.pm * 4 + (u.pn & 3)) * 2 + ai) * 4 + m) * 2 + bj) * 8 + wr * 4 + wc) * 64 + fq * 16 + fr)) * 8;
                        unsigned lo = 0u, hi = 0u;
#pragma unroll
                        for (int j = 0; j < 4; ++j) { lo |= (unsigned)(sigm(v0[j]) * 255.0f + 0.5f) << (8 * j); hi |= (unsigned)(sigm(v1[j]) * 255.0f + 0.5f) << (8 * j); }
                        u32x2 w8; w8.x = lo; w8.y = hi; *(u32x2*)gdst = w8; continue; }
                    *(u32x4*)dst = pack8(v0, v1);
                }
            }
    }
};
struct EpiPlain {
    static constexpr bool PERM = true;
    bf16* O; int ldc;
    DI void operator()(const AccT& acc, const Unit& u, int wr, int wc, int fr, int fq) const {
#pragma unroll
        for (int ai = 0; ai < 2; ++ai)
#pragma unroll
            for (int m = 0; m < 4; ++m) {
                const int r = u.pm * 256 + ai * 128 + wr * 64 + m * 16 + fr;
#pragma unroll
                for (int bj = 0; bj < 2; ++bj) { const int c = u.pn * 256 + bj * 128 + wc * 32 + 8 * fq;
                    *(u32x4*)(O + (size_t)r * ldc + c) = pack8(acc[ai][bj][m][0], acc[ai][bj][m][1]); }
            }
    }
};
template <bool ADD> struct EpiMerge {
    static constexpr bool PERM = true;
    bf16* MG; const bf16* GT;
    DI void operator()(const AccT& acc, const Unit& u, int wr, int wc, int fr, int fq) const {
#pragma unroll
        for (int ai = 0; ai < 2; ++ai)
#pragma unroll
            for (int m = 0; m < 4; ++m) {
                const int r = u.pm * 256 + ai * 128 + wr * 64 + m * 16 + fr;
#pragma unroll
                for (int bj = 0; bj < 2; ++bj) { const int c = u.pn * 256 + bj * 128 + wc * 32 + 8 * fq; const size_t o = (size_t)r * 1024 + c;
                    const size_t og = ((size_t)((((((u.pm * 4 + u.pn) * 2 + ai) * 4 + m) * 2 + bj) * 8 + wr * 4 + wc) * 64 + fq * 16 + fr)) * 8;
                    f32x4 g0, g1; { const u32x2 w8 = *(const u32x2*)((const unsigned char*)GT + og);
#pragma unroll
                        for (int j = 0; j < 4; ++j) { g0[j] = (float)((w8.x >> (8 * j)) & 255u) * (1.0f / 255.0f); g1[j] = (float)((w8.y >> (8 * j)) & 255u) * (1.0f / 255.0f); } }
                    f32x4 v0 = acc[ai][bj][m][0] * g0, v1 = acc[ai][bj][m][1] * g1;
                    if (ADD) { f32x4 p0, p1; unpack8(*(const u32x4*)(MG + o), p0, p1); v0 += p0; v1 += p1; }
                    *(u32x4*)(MG + o) = pack8(v0, v1); }
            }
    }
};
struct EpiMerge2 {
    static constexpr bool PERM = true;
    bf16* MG; const unsigned char* GF8; const unsigned char* GD8;
    DI void mid(AccT& acc, const Unit& u, int wr, int wc, int fr, int fq) const {
#pragma unroll
        for (int ai = 0; ai < 2; ++ai)
#pragma unroll
            for (int m = 0; m < 4; ++m)
#pragma unroll
                for (int bj = 0; bj < 2; ++bj) { const size_t og = ((size_t)((((((u.pm * 4 + u.pn) * 2 + ai) * 4 + m) * 2 + bj) * 8 + wr * 4 + wc) * 64 + fq * 16 + fr)) * 8;
                    const u32x2 f8 = *(const u32x2*)(GF8 + og), d8 = *(const u32x2*)(GD8 + og);
#pragma unroll
                    for (int j = 0; j < 4; ++j) { acc[ai][bj][m][0][j] *= (float)((f8.x >> (8 * j)) & 255u) * __builtin_amdgcn_rcpf(fmaxf((float)((d8.x >> (8 * j)) & 255u), 0.5f));
                                                  acc[ai][bj][m][1][j] *= (float)((f8.y >> (8 * j)) & 255u) * __builtin_amdgcn_rcpf(fmaxf((float)((d8.y >> (8 * j)) & 255u), 0.5f)); } }
    }
    DI void operator()(const AccT& acc, const Unit& u, int wr, int wc, int fr, int fq) const {
#pragma unroll
        for (int ai = 0; ai < 2; ++ai)
#pragma unroll
            for (int m = 0; m < 4; ++m) {
                const int r = u.pm * 256 + ai * 128 + wr * 64 + m * 16 + fr;
#pragma unroll
                for (int bj = 0; bj < 2; ++bj) { const int c = u.pn * 256 + bj * 128 + wc * 32 + 8 * fq; const size_t o = (size_t)r * 1024 + c;
                    const size_t og = ((size_t)((((((u.pm * 4 + u.pn) * 2 + ai) * 4 + m) * 2 + bj) * 8 + wr * 4 + wc) * 64 + fq * 16 + fr)) * 8;
                    const u32x2 d8 = *(const u32x2*)(GD8 + og); f32x4 v0, v1;
#pragma unroll
                    for (int j = 0; j < 4; ++j) { v0[j] = acc[ai][bj][m][0][j] * (fmaxf((float)((d8.x >> (8 * j)) & 255u), 0.5f) * (1.0f / 255.0f));
                                                  v1[j] = acc[ai][bj][m][1][j] * (fmaxf((float)((d8.y >> (8 * j)) & 255u), 0.5f) * (1.0f / 255.0f)); }
                    *(u32x4*)(MG + o) = pack8(v0, v1); }
            }
    }
};
struct EpiOut {
    static constexpr bool PERM = false;
    const float* X; float* H2;
    DI void operator()(const AccT& acc, const Unit& u, int wr, int wc, int fr, int fq) const {
#pragma unroll
        for (int ai = 0; ai < 2; ++ai)
#pragma unroll
            for (int m = 0; m < 4; ++m) {
                const int r = u.pm * 256 + ai * 128 + wr * 64 + m * 16 + fr;
#pragma unroll
                for (int bj = 0; bj < 2; ++bj)
#pragma unroll
                    for (int n = 0; n < 2; ++n) { const size_t o = (size_t)r * 1024 + u.pn * 256 + bj * 128 + wc * 32 + 16 * n + 4 * fq;
                        *(f32x4*)(H2 + o) = *(const f32x4*)(X + o) + acc[ai][bj][m][n]; }
            }
    }
};
struct EpiGU {
    static constexpr bool PERM = true;
    bf16* H;
    DI void operator()(const AccT& acc, const Unit& u, int wr, int wc, int fr, int fq) const {
#pragma unroll
        for (int ai = 0; ai < 2; ++ai)
#pragma unroll
            for (int m = 0; m < 4; ++m) {
                const int r = u.pm * 256 + ai * 128 + wr * 64 + m * 16 + fr;
                f32x4 v0, v1;
#pragma unroll
                for (int j = 0; j < 4; ++j) { v0[j] = siluf(acc[ai][0][m][0][j]) * acc[ai][1][m][0][j]; v1[j] = siluf(acc[ai][0][m][1][j]) * acc[ai][1][m][1][j]; }
                st16(H + (size_t)r * 256 + u.pn * 128 + wc * 32 + 8 * fq, pack8(v0, v1));
            }
    }
};
struct EpiDN {
    static constexpr bool PERM = true;
    unsigned char* ws; const LAS int* tab;
    DI void operator()(const AccT& acc, const Unit& u, int wr, int wc, int fr, int fq) const {
        bf16* tile = (bf16*)(ws + (u.pm < YA_SPLIT ? WS_YA_A + (size_t)u.pm * 524288 : WS_YA_B + (size_t)(u.pm - YA_SPLIT) * 524288));
        const int nv = tab[512 + u.pm];
#pragma unroll
        for (int ai = 0; ai < 2; ++ai)
#pragma unroll
            for (int m = 0; m < 4; ++m) {
                const int r = ai * 128 + wr * 64 + m * 16 + fr;
                if (r >= nv) continue;
#pragma unroll
                for (int bj = 0; bj < 2; ++bj) { const int c = u.pn * 256 + bj * 128 + wc * 32 + 8 * fq;
                    *(u32x4*)(tile + (size_t)r * 1024 + c) = pack8(acc[ai][bj][m][0], acc[ai][bj][m][1]); }
            }
    }
};

struct Args { const float* in[22]; float* out; unsigned char* ws; int ph_lo, ph_hi; };
struct Ctx {
    float* out; unsigned char* ws; unsigned char* lds; unsigned* ctl;
    int tid, lane, wave, G, bid, vcu, gw, ngw; bool dry;
};
DI const float* INP(int i) { return ((const float* const __attribute__((address_space(4)))*)__builtin_amdgcn_kernarg_segment_ptr())[i]; }

DI void tr_item(const float* W, int ldw, int k0, int c0, bf16* WT, int ldt, int drow0, const float* sc, int scmask, float* scr, int lane, bool dry = false) {
#pragma unroll 8
    for (int i = 0; i < 32; ++i) { const int kk = 2 * i + (lane >> 5); float v = W[(size_t)(k0 + kk) * ldw + c0 + (lane & 31)]; if (sc) v *= sc[(k0 + kk) & scmask]; scr[kk * 33 + (lane & 31)] = v; }
    LDS_WAIT();
    const int c = lane & 7;
#pragma unroll
    for (int j = 0; j < 4; ++j) { const int n = (lane >> 3) + 8 * j; const float* s = scr + (8 * c) * 33 + n;
        u32x4 o; o.x = pk2(s[0 * 33], s[1 * 33]); o.y = pk2(s[2 * 33], s[3 * 33]); o.z = pk2(s[4 * 33], s[5 * 33]); o.w = pk2(s[6 * 33], s[7 * 33]);
        if (!dry) *(u32x4*)(WT + (size_t)(drow0 + n) * ldt + k0 + 8 * c) = o; }
    LDS_WAIT();
}

DI void tr_item64(const float* W, int ldw, int k0, int c0, bf16* WT, int ldt, int drow_lo, int drow_hi, const float* sc, int scmask, float* scr, int lane, bool dry = false) {
    f32x4 v[16];
#pragma unroll
    for (int i = 0; i < 16; ++i) v[i] = *(const f32x4*)(W + (size_t)(k0 + 4 * i + (lane >> 4)) * ldw + c0 + 4 * (lane & 15));
#pragma unroll
    for (int i = 0; i < 16; ++i) { const int kk = 4 * i + (lane >> 4); f32x4 x = v[i]; if (sc) x *= sc[(k0 + kk) & scmask]; *(f32x4*)(scr + kk * 68 + 4 * (lane & 15)) = x; }
    LDS_WAIT();
    const int c = lane & 7;
#pragma unroll
    for (int j = 0; j < 8; ++j) { const int n = (lane >> 3) + 8 * j; const float* s0 = scr + (8 * c) * 68 + n;
        u32x4 o; o.x = pk2(s0[0 * 68], s0[1 * 68]); o.y = pk2(s0[2 * 68], s0[3 * 68]); o.z = pk2(s0[4 * 68], s0[5 * 68]); o.w = pk2(s0[6 * 68], s0[7 * 68]);
        const int dr = n < 32 ? drow_lo + n : drow_hi + (n - 32);
        if (!dry) *(u32x4*)(WT + (size_t)dr * ldt + k0 + 8 * c) = o; }
    LDS_WAIT();
}

DI void phase_prep(Ctx& F) {
    const float* x = INP(0); const float* meta = INP(1); const float* g1 = INP(2); const float* w_in = INP(3);
    bf16* XB = (bf16*)(F.ws + WS_XB); float* RSTD1 = (float*)(F.ws + WS_RSTD1); bf16* WTIN = (bf16*)(F.ws + WS_WTIN);
    for (int m0 = F.gw; m0 < NTOK + NMETA; m0 += 2 * F.ngw) {
        f32x4 v[2][4];
#pragma unroll
        for (int u = 0; u < 2; ++u) { const int m = m0 + u * F.ngw < NTOK + NMETA ? m0 + u * F.ngw : m0;
            const float* src = m < NTOK ? x + (size_t)m * 1024 : meta + (size_t)(m - NTOK) * 1024;
#pragma unroll
            for (int j = 0; j < 4; ++j) v[u][j] = ((const f32x4*)src)[F.lane + 64 * j]; }
#pragma unroll
        for (int u = 0; u < 2; ++u) { const int m = m0 + u * F.ngw; float s = 0.f;
#pragma unroll
            for (int j = 0; j < 4; ++j) s += (v[u][j][0] * v[u][j][0] + v[u][j][1] * v[u][j][1]) + (v[u][j][2] * v[u][j][2] + v[u][j][3] * v[u][j][3]);
            s = wave_sum(s);
            if (m < NTOK + NMETA) {
                const float rs = __builtin_amdgcn_rsqf(s * (1.0f / 1024.0f) + EPS);
                u32x2* o = (u32x2*)(XB + (size_t)m * 1024);
#pragma unroll
                for (int j = 0; j < 4; ++j) { u32x2 w; w.x = pk2(v[u][j][0] * rs, v[u][j][1] * rs); w.y = pk2(v[u][j][2] * rs, v[u][j][3] * rs); o[F.lane + 64 * j] = w; } } }
    }
    {
        float* scr = (float*)(F.lds + F.wave * 17408);
        constexpr int I_IN = 96 * 16, I_AB = 16, I_F = 16 * 8, I_D = 16 * 16;
        constexpr int NIT = I_IN + I_AB + I_F + I_D;
        for (int it = F.gw; it < NIT; it += F.ngw) {
            int r = it;
            if (r < I_IN) { const int nb = r >> 4, kb = r & 15, n0 = nb * 64; tr_item64(w_in, INW, kb * 64, n0 < 4096 ? n0 + 512 : n0 + 544, WTIN, 1024, n0, n0 + 32, g1, 1023, scr, F.lane); continue; } r -= I_IN;
            if (r < I_AB) { tr_item(w_in, INW, r * 64, 4608, (bf16*)(F.ws + WS_WAB), 1024, 0, g1, 1023, scr, F.lane); continue; } r -= I_AB;
            if (r < I_F) { const int nb = r >> 3, kb = r & 7; tr_item64(INP(10), 1024, kb * 64, nb * 64, (bf16*)(F.ws + WS_WF), 1536, nb * 64, nb * 64 + 32, nullptr, 0, scr, F.lane); continue; } r -= I_F;
            { const int nb = r >> 4, kb = r & 15; tr_item64(INP(11), 1024, kb * 64, nb * 64, (bf16*)(F.ws + WS_WF) + 512, 1536, nb * 64, nb * 64 + 32, INP(9), 127, scr, F.lane); }
        }
    }
    {
        float* WR = (float*)(F.ws + WS_WR); const float* g2 = INP(13); const float* wrg = INP(14); const float* wre = INP(16);
        for (int idx = F.gw * 64 + F.lane; idx < 72 * 1024; idx += F.ngw * 64) { const int j = idx >> 10, k = idx & 1023;
            WR[idx] = g2[k] * (j < 8 ? wrg[k * 8 + j] : wre[k * 64 + (j - 8)]); }
    }
    {
        bf16* XT = (bf16*)(F.ws + WS_XT);
        for (int idx = F.gw * 64 + F.lane; idx < 4096 * 12; idx += F.ngw * 64) { const int row = idx / 12, c = idx % 12;
            const int kap = c < 6 ? 2064 + 8 * c : 4176 + 8 * (c - 6);
            *(u32x4*)(XT + (size_t)row * KP + kap) = (u32x4){0u, 0u, 0u, 0u}; }
    }
    __syncthreads();
    for (int it = F.bid; it < 256; it += F.G) {
        const int g = it >> 6, k0 = (it & 63) * 16;
        float* Wl = (float*)F.lds; float* tc = Wl + 2048; float* tsn = tc + 128;
        { const int row = F.tid >> 5, c4 = (F.tid & 31) * 4; f32x4 v = *(const f32x4*)(w_in + (size_t)(k0 + row) * INW + g * 128 + c4); v *= g1[k0 + row]; *(f32x4*)(Wl + row * 128 + c4) = v; }
        if (F.tid < 128) { float s, c; sincospif((float)F.tid * (2.0f / 128.0f), &s, &c); tc[F.tid] = c; tsn[F.tid] = s; }
        __syncthreads();
        const int nl = F.tid & 255, kh = F.tid >> 8, mm = nl & 127; const float* tab = nl < 128 ? tc : tsn;
        float a[8];
#pragma unroll
        for (int j = 0; j < 8; ++j) a[j] = 0.f;
        for (int c = 0; c < 128; c += 4) { f32x4 tr;
#pragma unroll
            for (int e = 0; e < 4; ++e) tr[e] = tab[(mm * (c + e)) & 127];
#pragma unroll
            for (int j = 0; j < 8; ++j) { const f32x4 wv = *(const f32x4*)(Wl + (8 * kh + j) * 128 + c); a[j] += (wv[0] * tr[0] + wv[1] * tr[1]) + (wv[2] * tr[2] + wv[3] * tr[3]); } }
        const int np = (nl < 128 ? 0 : 512) + g * 128 + mm;
        u32x4 o; o.x = pk2(a[0], a[1]); o.y = pk2(a[2], a[3]); o.z = pk2(a[4], a[5]); o.w = pk2(a[6], a[7]);
        *(u32x4*)(WTIN + (size_t)(6144 + np) * 1024 + k0 + 8 * kh) = o;
        __syncthreads();
    }
    {
        float* tc = (float*)F.lds; float* tsn = tc + 2064; const float SC = __builtin_amdgcn_rsqf(2064.0f * 128.0f);
        for (int r = F.tid; r < 2064; r += 512) { float s, c; sincospif((float)r * (2.0f / 2064.0f), &s, &c); tc[r] = c * SC; tsn[r] = -s * SC; }
        __syncthreads();
        bf16* DM = (bf16*)(F.ws + WS_DM);
        const int nrows = (2048 - F.bid + F.G - 1) / F.G;
        for (int idx = F.tid; idx < nrows * (KP / 8); idx += 512) { const int ri = idx / (KP / 8), c8 = idx - ri * (KP / 8), i = F.bid + F.G * ri, k = 16 + i; float v[8];
            const int kap0 = c8 * 8; const float* tabp = nullptr; int m = 0;
            if (kap0 < 2064) { tabp = tc; m = (k * kap0) % 2064; } else if (kap0 >= KSIN && kap0 < KSIN + 2064) { tabp = tsn; m = (k * (kap0 - KSIN)) % 2064; }
#pragma unroll
            for (int e = 0; e < 8; ++e) { v[e] = tabp ? tabp[m] : 0.f; m += k; if (m >= 2064) m -= 2064; }
            u32x4 o; o.x = pk2(v[0], v[1]); o.y = pk2(v[2], v[3]); o.z = pk2(v[4], v[5]); o.w = pk2(v[6], v[7]);
            *(u32x4*)(DM + (size_t)i * KP + c8 * 8) = o; }
        __syncthreads();
    }
}

DI f32x4 mini_tile(const bf16* A16, const bf16* B16, int lane) {
    f32x4 acc = {0.f, 0.f, 0.f, 0.f};
    const bf16x8* ap = (const bf16x8*)(A16 + (lane & 15) * 1024 + 8 * (lane >> 4));
    const bf16x8* bp = (const bf16x8*)(B16 + (lane & 15) * 1024 + 8 * (lane >> 4));
#pragma unroll 8
    for (int kk = 0; kk < 32; ++kk) acc = __builtin_amdgcn_mfma_f32_16x16x32_bf16(ap[4 * kk], bp[4 * kk], acc, 0, 0, 0);
    return acc;
}
DI void phase_inproj(Ctx& F) {
    const bf16* XB = (const bf16*)(F.ws + WS_XB); const bf16* WTIN = (const bf16*)(F.ws + WS_WTIN); const float* RSTD1 = (const float*)(F.ws + WS_RSTD1);
    bf16* XT = (bf16*)(F.ws + WS_XT); bf16* QKVP = (bf16*)(F.ws + WS_QKVP); float* GB = (float*)(F.ws + WS_GB);
    const int q = F.lane >> 4, col = F.lane & 15;
    const bool mini_first = (F.vcu & 1) != 0;
#pragma unroll 1
    for (int pass = 0; pass < 2; ++pass) {
    if ((pass == 0) == mini_first) {
    for (int it = F.gw; it < 256 + 2050; it += F.ngw) {
        if (it < 256) {
            const int wrow = it < 64 ? 6144 + 16 * it : 16 * (it - 64);
            f32x4 acc = mini_tile(XB + (size_t)NTOK * 1024, WTIN + (size_t)wrow * 1024, F.lane);
            if (it < 64) { const int np = 16 * it + col; u32x2 w; w.x = pk2(acc[0], acc[1]); w.y = pk2(acc[2], acc[3]);
                for (int b = 0; b < NB; ++b) *(u32x2*)(XT + ((size_t)(b * 512 + (np & 511)) * KP + (np >= 512 ? KSIN : 0) + 4 * q)) = w; }
            else { const int n = 16 * (it - 64) + col;
                for (int b = 0; b < NB; ++b)
#pragma unroll
                    for (int r = 0; r < 4; ++r) { QKVP[(size_t)(b * LTOK + 4 * q + r) * 3072 + n] = (bf16)f2bf(acc[r]);
                        if (4 * q + r >= 14) ((bf16*)(F.ws + WS_HALO))[(size_t)((b * 32 + 0) * 4 + (4 * q + r - 14)) * 3072 + n] = (bf16)f2bf(acc[r]); } }
        } else {
            const int a = it - 256, rg = a >> 1, cgp = a & 1;
            f32x4 acc = mini_tile(XB + (size_t)rg * 16 * 1024, (const bf16*)(F.ws + WS_WAB) + (size_t)cgp * 16 * 1024, F.lane);
            const int j = cgp * 16 + col, ty = j >> 3, h = j & 7;
            const float alog = (ty & 2) ? INP(7)[h] : INP(5)[h], dtb = (ty & 2) ? INP(8)[h] : INP(6)[h];
#pragma unroll
            for (int r = 0; r < 4; ++r) { const int t = rg * 16 + 4 * q + r; const float v = acc[r];
                const float o = (ty & 1) ? sigm(v) : -__expf(alog) * softplusf(v + dtb);
                if (t < NTOK) GB[((size_t)(ty * NB + (t >> 11)) * NHEAD + h) * LTOK + 16 + (t & 2047)] = o;
                else for (int b = 0; b < NB; ++b) GB[((size_t)(ty * NB + b) * NHEAD + h) * LTOK + (t - NTOK)] = o; }
        }
    }
    }
    if (pass == 0) {
    __syncthreads();
    { pg8::Gemm g{WTIN + (size_t)6144 * 1024, XB, 1024}; pg8::StaticOrder S; S.init(1024, NTOK, F.G, F.bid); EpiXT E{XT, RSTD1};
      pg8::gemm_phase((PG8_LAS unsigned char*)F.lds, g, S, E, F.wave); }
    { pg8::Gemm g{XB, WTIN, 1024}; pg8::StaticOrder S; S.init(NTOK, 6144, F.G, F.bid);
      EpiIn E{QKVP, (bf16*)(F.ws + WS_Z), (bf16*)F.out, (bf16*)F.out + (size_t)NTOK * 1024, RSTD1, (bf16*)(F.ws + WS_HALO)};
      pg8::gemm_phase((PG8_LAS unsigned char*)F.lds, g, S, E, F.wave); }
    }
    }
}

DI int permpos(int d) { const int o = d & 31; return (d & ~31) + ((o >> 2) & 3) * 8 + (o >> 4) * 4 + (o & 3); }
DI float incl_scan(float v, int lane) {
#pragma unroll
    for (int o = 1; o < 64; o <<= 1) { const float t = __shfl_up(v, o); if (lane >= o) v += t; }
    return v;
}
DI void diag_inverse4(float* A, int lane) {
    const int blk = lane >> 4, c = lane & 15; float* N = A + (16 * blk) * 68 + 16 * blk;
    float t[16]; t[0] = c == 0 ? 1.f : 0.f;
#pragma unroll
    for (int i = 1; i < 16; ++i) { float acc = c == i ? 1.f : 0.f;
#pragma unroll
        for (int j4 = 0; j4 < (i + 3) / 4; ++j4) { const f32x4 a = *(const f32x4*)(N + i * 68 + 4 * j4);
#pragma unroll
            for (int e = 0; e < 4; ++e) if (4 * j4 + e < i) acc -= a[e] * t[4 * j4 + e]; }
        t[i] = acc; }
#pragma unroll
    for (int i = 0; i < 16; ++i) N[i * 68 + c] = t[i];
}
DI f32x4 blk_mma(const float* Ab, int lda, const float* Bb, int ldb, f32x4 acc, int lane) {
#pragma unroll
    for (int s4 = 0; s4 < 4; ++s4) acc = __builtin_amdgcn_mfma_f32_16x16x4f32(Ab[(lane & 15) * lda + 4 * s4 + (lane >> 4)], Bb[(4 * s4 + (lane >> 4)) * ldb + (lane & 15)], acc, 0, 0, 0);
    return acc;
}
DI void tri_inverse64_blocked(float* A4, float* xs, bool active, int wave, int lane) {
    float* A = A4 + (wave >> 1) * (64 * 68); const int w2 = wave & 1; float* X0 = xs + wave * 512; float* X1 = X0 + 256;
    if (active && w2 == 0) diag_inverse4(A, lane);
    __syncthreads();
#pragma unroll
    for (int I = 1; I < 4; ++I) {
        const int j0 = w2 == 0 ? 0 : 1;
        const int nj = w2 == 0 ? 1 : (I - 1);
        if (active) {
#pragma unroll
            for (int jj = 0; jj < 2; ++jj) { if (jj < nj) { const int j = j0 + jj; f32x4 x = {0.f, 0.f, 0.f, 0.f};
#pragma unroll
                for (int k = 0; k < 3; ++k) if (k >= j && k < I) x = blk_mma(A + (16 * I) * 68 + 16 * k, 68, A + (16 * k) * 68 + 16 * j, 68, x, lane);
                float* X = jj ? X1 : X0;
#pragma unroll
                for (int r = 0; r < 4; ++r) X[(4 * (lane >> 4) + r) * 16 + (lane & 15)] = x[r]; } }
        }
        __syncthreads();
        if (active) {
#pragma unroll
            for (int jj = 0; jj < 2; ++jj) { if (jj < nj) { const int j = j0 + jj; f32x4 y = {0.f, 0.f, 0.f, 0.f};
                y = blk_mma(A + (16 * I) * 68 + 16 * I, 68, jj ? X1 : X0, 16, y, lane);
#pragma unroll
                for (int r = 0; r < 4; ++r) A[(16 * I + 4 * (lane >> 4) + r) * 68 + 16 * j + (lane & 15)] = -y[r]; } }
        }
        __syncthreads();
    }
}

constexpr int PL_P = 0, PL_Q = 52224, PL_K = 69632, PL_A = 87040, PL_G = 156672;
struct PRegs { u32x4 v[7]; };
DI void prep_load_regs(Ctx& F, int it, PRegs& R) {
    const int tid0 = F.wave * 64 + lane_id();
    const int bh = it / 33, cc = it - bh * 33, b = bh >> 3, h = bh & 7, l0 = 64 * cc - 48;
    const bf16* qkv = (const bf16*)(F.ws + WS_QKVP) + (size_t)b * LTOK * 3072; const bf16* halo = (const bf16*)(F.ws + WS_HALO) + (size_t)b * 32 * 4 * 3072;
#pragma unroll
    for (int n = 0; n < 7; ++n) { const int idx = tid0 + 512 * n; u32x4 v = {0u, 0u, 0u, 0u};
        if (idx < 68 * 48) { const int pr = idx / 48, rem = idx - pr * 48, part = rem >> 4, c16 = rem & 15, l = l0 - 2 + pr, chb = part * 1024 + h * 128;
            if (pr < 2) { if (cc >= 1) v = *(const u32x4*)(halo + ((size_t)((cc - 1) * 4 + pr) * 3072 + chb + 8 * c16)); }
            else if (pr >= 66) { if (cc <= 31) v = *(const u32x4*)(halo + ((size_t)(cc * 4 + pr - 64) * 3072 + chb + 8 * c16)); }
            else if (l >= 0) v = *(const u32x4*)(qkv + ((size_t)l * 3072 + chb + 8 * c16)); }
        R.v[n] = v; }
}
DI void prep_store_regs(Ctx& F, const PRegs& R) {
    bf16* P = (bf16*)(F.lds + 0); const int tid0 = F.wave * 64 + lane_id();
#pragma unroll
    for (int n = 0; n < 7; ++n) { const int idx = tid0 + 512 * n;
        if (idx < 68 * 48) { const int pr = idx / 48, rem = idx - pr * 48, part = rem >> 4, c16 = rem & 15; *(u32x4*)(P + (part * 68 + pr) * 128 + 8 * c16) = R.v[n]; } }
}
DI void prep_item_conv(Ctx& F, int b, int h, int cc, int slot) {
    bf16* qkv = (bf16*)(F.ws + WS_QKVP) + (size_t)b * LTOK * 3072;
    const float* cw = INP(4); const float* GB = (const float*)(F.ws + WS_GB);
    bf16* P = (bf16*)(F.lds + PL_P); bf16* Qs = (bf16*)(F.lds + PL_Q); bf16* Ks = (bf16*)(F.lds + PL_K);
    float* Gs = (float*)(F.lds + PL_G) + slot * 256; float* Bs = Gs + 128;
    const int lane = lane_id(), wave = F.wave, l0 = 64 * cc - 48;
    if (wave < 2) { const int isrc = wave ? 63 - lane : lane; const int l = l0 + isrc; float g = 0.f, be = 0.f;
        if (l >= 0) { g = GB[((size_t)((wave * 2) * NB + b) * NHEAD + h) * LTOK + l]; be = GB[((size_t)((wave * 2 + 1) * NB + b) * NHEAD + h) * LTOK + l]; }
        const float gc = incl_scan(g, lane); Gs[wave * 64 + lane] = gc; Bs[wave * 64 + lane] = be;
        if (!F.dry) ((float*)(F.ws + WS_GCUM))[((size_t)(wave * 64 + b * NHEAD + h) * 33 + cc) * 64 + lane] = gc; }
    const int c16 = lane & 15, r4 = lane >> 4;
    f32x4 wall[3][5][2];
#pragma unroll
    for (int part = 0; part < 3; ++part)
#pragma unroll
        for (int j = 0; j < 5; ++j) { const float* wp = cw + j * 3072 + part * 1024 + h * 128 + 8 * c16; wall[part][j][0] = *(const f32x4*)wp; wall[part][j][1] = *(const f32x4*)(wp + 4); }
    __syncthreads();
    {
#pragma unroll
      for (int part = 0; part < 3; ++part) { const int chb = part * 1024 + h * 128;
          f32x4 w[5][2];
#pragma unroll
          for (int j = 0; j < 5; ++j) { w[j][0] = wall[part][j][0]; w[j][1] = wall[part][j][1]; }
#pragma unroll
          for (int it2 = 0; it2 < 2; ++it2) { const int i = wave * 8 + it2 * 4 + r4, l = l0 + i;
              f32x4 a0 = {0.f, 0.f, 0.f, 0.f}, a1 = {0.f, 0.f, 0.f, 0.f};
#pragma unroll
              for (int j = 0; j < 5; ++j) { f32x4 p0, p1; unpack8(*(const u32x4*)(P + (part * 68 + i + j) * 128 + 8 * c16), p0, p1); a0 += p0 * w[j][0]; a1 += p1 * w[j][1]; }
#pragma unroll
              for (int e = 0; e < 4; ++e) { a0[e] = siluf(a0[e]); a1[e] = siluf(a1[e]); }
              if (part < 2) { float ss = (a0[0] * a0[0] + a0[1] * a0[1]) + (a0[2] * a0[2] + a0[3] * a0[3]) + (a1[0] * a1[0] + a1[1] * a1[1]) + (a1[2] * a1[2] + a1[3] * a1[3]);
                  ss += __shfl_xor(ss, 1); ss += __shfl_xor(ss, 2); ss += __shfl_xor(ss, 4); ss += __shfl_xor(ss, 8);
                  const float rn = (part == 0 ? 0.08838834764831845f : 1.0f) * __builtin_amdgcn_rsqf(ss + EPS); a0 *= rn; a1 *= rn; }
              const u32x4 o = pack8(a0, a1);
              if (l >= 0 && !F.dry) *(u32x4*)(qkv + ((size_t)l * 3072 + chb + 8 * c16)) = o;
              if (part == 0) *(u32x4*)(Qs + i * 136 + 8 * c16) = o; else if (part == 1) *(u32x4*)(Ks + i * 136 + 8 * c16) = o; } } }
    __syncthreads();
}
DI void prep_item_gram(Ctx& F, int b, int h, int cc, int slot) {
    bf16* Qs = (bf16*)(F.lds + PL_Q); bf16* Ks = (bf16*)(F.lds + PL_K);
    float* Gs = (float*)(F.lds + PL_G) + slot * 256; float* Bs = Gs + 128;
    const int lane = lane_id(), wave = F.wave, tid = wave * 64 + lane;
    float* Af = (float*)(F.lds + PL_A) + (slot * 2 + 0) * (64 * 68); float* Ab = Af + 64 * 68;
    bf16* QKfi = (bf16*)(F.lds + PL_P); bf16* QKbi = QKfi + 4096;
    for (int tt = 0; tt < 4; ++tt) { const int id = wave * 4 + tt, which = id >> 4, mt = (id >> 2) & 3, nt = id & 3;
        const bf16* Ap = (which ? Qs : Ks) + (16 * mt + (lane & 15)) * 136 + 8 * (lane >> 4); const bf16* Bp = Ks + (16 * nt + (lane & 15)) * 136 + 8 * (lane >> 4);
        f32x4 acc = {0.f, 0.f, 0.f, 0.f};
#pragma unroll
        for (int kk = 0; kk < 4; ++kk) acc = __builtin_amdgcn_mfma_f32_16x16x32_bf16(*(const bf16x8*)(Ap + 32 * kk), *(const bf16x8*)(Bp + 32 * kk), acc, 0, 0, 0);
        const int j = 16 * nt + (lane & 15), jb = 63 - j; const float gfj = Gs[j], gbj = Gs[64 + jb];
#pragma unroll
        for (int r = 0; r < 4; ++r) { const int i = 16 * mt + 4 * (lane >> 4) + r, ib = 63 - i;
            const float df = __expf(Gs[i] - gfj), db = __expf(Gs[64 + ib] - gbj);
            if (which == 0) { Af[i * 68 + j] = (i > j) ? Bs[i] * acc[r] * df : 0.f; Ab[ib * 68 + jb] = (ib > jb) ? Bs[64 + ib] * acc[r] * db : 0.f; }
            else { QKfi[i * 64 + permpos(j)] = (bf16)f2bf((i >= j) ? acc[r] * df : 0.f); QKbi[ib * 64 + permpos(jb)] = (bf16)f2bf((ib >= jb) ? acc[r] * db : 0.f); } } }
    __syncthreads();
    { bf16* outp = (bf16*)(F.ws + WS_TQK) + ((size_t)(b * NHEAD + h) * 65) * 8192;
      const int i = tid >> 3, c = tid & 7;
      if (!F.dry) *(u32x4*)(outp + (size_t)cc * 8192 + 4096 + i * 64 + 8 * c) = *(const u32x4*)(QKfi + i * 64 + 8 * c);
      if (cc > 0 && !F.dry) *(u32x4*)(outp + (size_t)(32 + cc) * 8192 + 4096 + i * 64 + 8 * c) = *(const u32x4*)(QKbi + i * 64 + 8 * c); }
    __syncthreads();
}
DI void prep_tail(Ctx& F, int it0) {
    { const int m = F.wave >> 1, k = m >> 1, dir = m & 1; const int cc = (it0 + k) % 33;
      tri_inverse64_blocked((float*)(F.lds + PL_A), (float*)(F.lds + PL_P), !(dir == 1 && cc == 0), F.wave, F.lane); }
    { const int m = F.tid >> 7, i = (F.tid & 127) >> 1, half = F.tid & 1, k = m >> 1, dir = m & 1; const int it = it0 + k, bh = it / 33, cc = it % 33;
      if (!(dir == 1 && cc == 0) && !F.dry) { const float* A = (const float*)(F.lds + PL_A) + m * (64 * 68) + i * 68 + 32 * half;
          bf16* dst = (bf16*)(F.ws + WS_TQK) + ((size_t)bh * 65 + (dir ? 32 + cc : cc)) * 8192 + i * 64 + 32 * half;
#pragma unroll
          for (int qq = 0; qq < 4; ++qq) { u32x4 o; o.x = pk2(A[4 * qq + 0], A[4 * qq + 1]); o.y = pk2(A[4 * qq + 2], A[4 * qq + 3]); o.z = pk2(A[16 + 4 * qq + 0], A[16 + 4 * qq + 1]); o.w = pk2(A[16 + 4 * qq + 2], A[16 + 4 * qq + 3]);
              *(u32x4*)(dst + 8 * qq) = o; } } }
    __syncthreads();
}
DI void phase_dft_prep(Ctx& F) {
    { pg8::Gemm g{(const bf16*)(F.ws + WS_DM), (const bf16*)(F.ws + WS_XT), KP}; pg8::DftOrder S{F.G, F.vcu}; EpiPlain E{(bf16*)(F.ws + WS_FM), 512};
      pg8::gemm_phase((PG8_LAS unsigned char*)F.lds, g, S, E, F.wave); }
    volatile int* qs = (volatile int*)(F.lds + LDS_BARW + 64);
    constexpr int NR = (64 * 33) / 2;
    unsigned* qhead = F.ctl + CW_PREPQ + (F.dry ? 64 : 0);
    if (F.tid == 0) qs[0] = (int)atomicAdd(qhead, 1u);
    __syncthreads();
    int rd = qs[0];
    PRegs pr;
    if (rd < NR) prep_load_regs(F, 2 * rd, pr);
    while (rd < NR) {
        const int it0 = 2 * rd;
        if (F.tid == 0) qs[1] = (int)atomicAdd(qhead, 1u);
        int rdn = NR;
#pragma unroll 1
        for (int k = 0; k < 2; ++k) {
            prep_store_regs(F, pr);
            if (k == 0) prep_load_regs(F, it0 + 1, pr);
            else { rdn = qs[1]; if (rdn < NR) prep_load_regs(F, 2 * rdn, pr); }
            const int it = it0 + k, bh = it / 33, cc = it - bh * 33;
            prep_item_conv(F, bh >> 3, bh & 7, cc, k); prep_item_gram(F, bh >> 3, bh & 7, cc, k);
        }
        prep_tail(F, it0);
        rd = rdn;
    }
}

DI bf16x8 packB(f32x4 lo, f32x4 hi) { return __builtin_bit_cast(bf16x8, pack8(lo, hi)); }
typedef short s16x4 __attribute__((ext_vector_type(4)));
constexpr int SB_K = 0, SB_Q = 16384, SB_V = 32768, SB_T = 49152, SB_QK = 57344, SB_BYTES = 65536;
DI void scan_dma(Ctx& F, unsigned char* buf, const bf16* qkv  , const bf16* zero, const bf16* tq, int h, int dir, int cc, int half) {
    const int lane = F.lane, wave = F.wave - 4, l0 = 64 * cc - 48;
#pragma unroll
    for (int n2 = 0; n2 < 4; ++n2) { const int n = 4 * wave + n2, row = 4 * n + (lane >> 4), cl = lane & 15, cg = cl ^ (row & 15);
        const int l = l0 + (dir ? 63 - row : row);
#pragma unroll
        for (int part = 0; part < 2; ++part) { const bf16* src = l >= 0 ? qkv + ((size_t)l * 3072 + part * 1024 + h * 128 + 8 * cg) : zero;
            const int boff = (part == 0 ? SB_Q : SB_K) + n * 1024;
            __builtin_amdgcn_global_load_lds((const unsigned*)src, (LAS unsigned*)((LAS unsigned char*)buf + boff), 16, 0, 0); } }
#pragma unroll
    for (int n2 = 0; n2 < 2; ++n2) { const int n = 2 * wave + n2, row = 8 * n + (lane >> 3), cl = lane & 7, cg = cl ^ ((row >> 1) & 7);
      const int l = l0 + (dir ? 63 - row : row);
      const bf16* vsrc = l >= 0 ? qkv + ((size_t)l * 3072 + 2048 + h * 128 + 64 * half + 8 * cg) : zero;
      __builtin_amdgcn_global_load_lds((const unsigned*)vsrc, (LAS unsigned*)((LAS unsigned char*)buf + SB_V + n * 1024), 16, 0, 0);
      const bf16* Tg = tq + (size_t)(dir ? 32 + cc : cc) * 8192;
      __builtin_amdgcn_global_load_lds((const unsigned*)(Tg + row * 64 + 8 * cg), (LAS unsigned*)((LAS unsigned char*)buf + SB_T + n * 1024), 16, 0, 0);
      __builtin_amdgcn_global_load_lds((const unsigned*)(Tg + 4096 + row * 64 + 8 * cg), (LAS unsigned*)((LAS unsigned char*)buf + SB_QK + n * 1024), 16, 0, 0); }
}
constexpr int SB_OST = 131072, SB_ROW = 147456;
DI void scan_flush(Ctx& F, bf16* Og, int b, int h, int dir, int cc, int half, int stg) {
#pragma unroll
    for (int i = 0; i < 2; ++i) { const int tq = F.tid - 256, row = (tq >> 3) + 32 * i, c = tq & 7, isrc = dir ? 63 - row : row; const int t = b * SEQ + 64 * (cc - 1) + isrc;
        *(u32x4*)(Og + (size_t)t * 1024 + h * 128 + 64 * half + 8 * c) = *(const u32x4*)(F.lds + SB_OST + stg * 8192 + row * 128 + c * 16); }
}
DI void scan_chain(Ctx& F, int b, int h, int dir, int half) {
    const bf16* qkv = (const bf16*)(F.ws + WS_QKVP) + (size_t)b * LTOK * 3072; const float* GB = (const float*)(F.ws + WS_GB);
    const bf16* zero = (const bf16*)(F.ctl + CW_ZERO); const bf16* tq = (const bf16*)(F.ws + WS_TQK) + ((size_t)(b * NHEAD + h) * 65) * 8192;
    bf16* Og = (bf16*)(F.ws + (dir ? WS_OB : WS_OF));
    const int lane = F.lane, wave = F.wave, q = lane >> 4, col = lane & 15, dvl = 16 * (wave & 3) + col; const bool cw = wave < 4;
    const float* gC = (const float*)(F.ws + WS_GCUM) + ((size_t)(dir * 64 + b * NHEAD + h) * 33) * 64; const float* gBe = GB + ((size_t)((dir * 2 + 1) * NB + b) * NHEAD + h) * LTOK;
    float* rowsc = (float*)(F.lds + SB_ROW + wave * 512);
    f32x4 S[8];
#pragma unroll
    for (int i = 0; i < 8; ++i) S[i] = (f32x4){0.f, 0.f, 0.f, 0.f};
    const int nsteps = dir ? 32 : 33;
    float gn = 0.f, ben = 0.f;
    { const int cc = dir ? 32 : 0; if (!cw) scan_dma(F, F.lds, qkv, zero, tq, h, dir, cc, half);
      if (cw) { const int l = 64 * cc - 48 + (dir ? 63 - lane : lane); gn = gC[cc * 64 + lane]; ben = 0.f; if (l >= 0) ben = gBe[l]; } }
    VM_WAIT(); __syncthreads();
    int ccprev = 0;
    for (int st = 0; st < nsteps; ++st) {
        const int cc = dir ? 32 - st : st;
        unsigned char* buf = F.lds + (st & 1) * SB_BYTES;
        if (cw) { rowsc[lane] = gn; rowsc[64 + lane] = ben;
            if (st + 1 < nsteps) { const int ccn = dir ? 32 - (st + 1) : st + 1; const int l = 64 * ccn - 48 + (dir ? 63 - lane : lane); gn = gC[ccn * 64 + lane]; ben = 0.f; if (l >= 0) ben = gBe[l]; }
        } else {
            if (st + 1 < nsteps) { const int ccn = dir ? 32 - (st + 1) : st + 1; scan_dma(F, F.lds + ((st + 1) & 1) * SB_BYTES, qkv, zero, tq, h, dir, ccn, half); }
            if (ccprev > 0) scan_flush(F, Og, b, h, dir, ccprev, half, (st + 1) & 1); }
        LDS_WAIT();
        f32x4 O[4], VN[4]; float eD[4][4]; float dec = 0.f;
        if (cw) {
            const float Glast = rowsc[63]; dec = __expf(Glast);
            float eG[4][4], be[4][4];
#pragma unroll
            for (int mt = 0; mt < 4; ++mt) { const f32x4 g4 = *(const f32x4*)(rowsc + 16 * mt + 4 * q), b4 = *(const f32x4*)(rowsc + 64 + 16 * mt + 4 * q);
#pragma unroll
                for (int r = 0; r < 4; ++r) { eG[mt][r] = __expf(g4[r]); eD[mt][r] = __expf(Glast - g4[r]); be[mt][r] = b4[r]; } }
            bf16x8 bS[4];
#pragma unroll
            for (int ks = 0; ks < 4; ++ks) bS[ks] = packB(S[2 * ks], S[2 * ks + 1]);
            f32x4 R[4];
#pragma unroll
            for (int mt = 0; mt < 4; ++mt) { const int row = 16 * mt + col; f32x4 Pm = {0.f, 0.f, 0.f, 0.f}; O[mt] = (f32x4){0.f, 0.f, 0.f, 0.f};
#pragma unroll
                for (int ks = 0; ks < 4; ++ks) { const int off = row * 256 + (((4 * ks + q) ^ (row & 15)) << 4);
                    Pm = __builtin_amdgcn_mfma_f32_16x16x32_bf16(*(const bf16x8*)(buf + SB_K + off), bS[ks], Pm, 0, 0, 0);
                    O[mt] = __builtin_amdgcn_mfma_f32_16x16x32_bf16(*(const bf16x8*)(buf + SB_Q + off), bS[ks], O[mt], 0, 0, 0); }
#pragma unroll
                for (int r = 0; r < 4; ++r) { const int c = 16 * mt + 4 * q + r;
                    const float v = bf2f(*(const bf16*)(buf + SB_V + c * 128 + ((((dvl >> 3) ^ ((c >> 1) & 7)) << 4) + (dvl & 7) * 2)));
                    R[mt][r] = be[mt][r] * (v - eG[mt][r] * Pm[r]); O[mt][r] *= eG[mt][r]; } }
            bf16x8 bR[2] = {packB(R[0], R[1]), packB(R[2], R[3])};
#pragma unroll
            for (int mt = 0; mt < 4; ++mt) { const int row = 16 * mt + col; VN[mt] = (f32x4){0.f, 0.f, 0.f, 0.f};
#pragma unroll
                for (int ks = 0; ks < 2; ++ks) { if (mt < 2 && ks == 1) continue; const int off = row * 128 + (((4 * ks + q) ^ ((row >> 1) & 7)) << 4);
                    VN[mt] = __builtin_amdgcn_mfma_f32_16x16x32_bf16(*(const bf16x8*)(buf + SB_T + off), bR[ks], VN[mt], 0, 0, 0); } }
            bf16x8 bV[2] = {packB(VN[0], VN[1]), packB(VN[2], VN[3])};
#pragma unroll
            for (int mt = 0; mt < 4; ++mt) { const int row = 16 * mt + col;
#pragma unroll
                for (int ks = 0; ks < 2; ++ks) { if (mt < 2 && ks == 1) continue; const int off = row * 128 + (((4 * ks + q) ^ ((row >> 1) & 7)) << 4);
                    O[mt] = __builtin_amdgcn_mfma_f32_16x16x32_bf16(*(const bf16x8*)(buf + SB_QK + off), bV[ks], O[mt], 0, 0, 0); } }
        }
        if (cw) {
            if (cc > 0) {
#pragma unroll
                for (int mt = 0; mt < 4; ++mt)
#pragma unroll
                    for (int r = 0; r < 4; ++r) *(bf16*)(F.lds + SB_OST + (st & 1) * 8192 + (16 * mt + 4 * q + r) * 128 + dvl * 2) = (bf16)f2bf(O[mt][r]); }
#pragma unroll
            for (int mt = 0; mt < 4; ++mt)
#pragma unroll
                for (int r = 0; r < 4; ++r) VN[mt][r] *= eD[mt][r];
            bf16x8 bD[2] = {packB(VN[0], VN[1]), packB(VN[2], VN[3])};
            const int rp = (lane >> 2) & 3, p = lane & 3;
            const unsigned kbase = (unsigned)(size_t)(LAS unsigned char*)(buf + SB_K);
#pragma unroll
            for (int th = 0; th < 4; ++th) {
                const unsigned addr = kbase + (unsigned)((4 * q + rp) * 256 + 64 * (th ^ q) + 16 * (p ^ rp));
                s16x4 f0, f1, f2, f3, f4, f5, f6, f7;
                asm volatile("ds_read_b64_tr_b16 %0, %8\n\tds_read_b64_tr_b16 %1, %8 offset:4096\n\tds_read_b64_tr_b16 %2, %8 offset:8192\n\tds_read_b64_tr_b16 %3, %8 offset:12288\n\t"
                             "ds_read_b64_tr_b16 %4, %8 offset:8\n\tds_read_b64_tr_b16 %5, %8 offset:4104\n\tds_read_b64_tr_b16 %6, %8 offset:8200\n\tds_read_b64_tr_b16 %7, %8 offset:12296\n\ts_waitcnt lgkmcnt(0)"
                             : "=&v"(f0), "=&v"(f1), "=&v"(f2), "=&v"(f3), "=&v"(f4), "=&v"(f5), "=&v"(f6), "=&v"(f7) : "v"(addr) : "memory");
                const bf16x8 a00 = __builtin_shufflevector(f0, f1, 0, 1, 2, 3, 4, 5, 6, 7), a01 = __builtin_shufflevector(f2, f3, 0, 1, 2, 3, 4, 5, 6, 7);
                const bf16x8 a10 = __builtin_shufflevector(f4, f5, 0, 1, 2, 3, 4, 5, 6, 7), a11 = __builtin_shufflevector(f6, f7, 0, 1, 2, 3, 4, 5, 6, 7);
                S[2 * th] *= dec; S[2 * th + 1] *= dec;
                S[2 * th] = __builtin_amdgcn_mfma_f32_16x16x32_bf16(a00, bD[0], S[2 * th], 0, 0, 0); S[2 * th] = __builtin_amdgcn_mfma_f32_16x16x32_bf16(a01, bD[1], S[2 * th], 0, 0, 0);
                S[2 * th + 1] = __builtin_amdgcn_mfma_f32_16x16x32_bf16(a10, bD[0], S[2 * th + 1], 0, 0, 0); S[2 * th + 1] = __builtin_amdgcn_mfma_f32_16x16x32_bf16(a11, bD[1], S[2 * th + 1], 0, 0, 0);
            }
        }
        ccprev = cc;
        VM_WAIT(); __syncthreads();
    }
    if (!cw && ccprev > 0) scan_flush(F, Og, b, h, dir, ccprev, half, (nsteps + 1) & 1);
    __syncthreads();
}
DI void phase_scan(Ctx& F) { for (int it = F.bid; it < 256; it += F.G) { const int ch = it & 127; scan_chain(F, ch >> 4, (ch >> 1) & 7, ch & 1, it >> 7); } }

DI void phase_og_wexp(Ctx& F) {
    bf16* OF = (bf16*)(F.ws + WS_OF); const bf16* OB = (const bf16*)(F.ws + WS_OB); const bf16* Z = (const bf16*)(F.ws + WS_Z);
    for (int t = F.gw; t < NTOK; t += F.ngw) { const size_t o = (size_t)t * 1024 + 16 * F.lane; float v[16]; float ss = 0.f;
#pragma unroll
        for (int hh = 0; hh < 2; ++hh) { f32x4 a0, a1, b0, b1; unpack8(*(const u32x4*)(OF + o + 8 * hh), a0, a1); unpack8(*(const u32x4*)(OB + o + 8 * hh), b0, b1); a0 += b0; a1 += b1;
#pragma unroll
            for (int j = 0; j < 4; ++j) { v[8 * hh + j] = a0[j]; v[8 * hh + 4 + j] = a1[j]; ss += a0[j] * a0[j] + a1[j] * a1[j]; } }
        ss += __shfl_xor(ss, 1); ss += __shfl_xor(ss, 2); ss += __shfl_xor(ss, 4);
        const float rs = __builtin_amdgcn_rsqf(ss * (1.0f / 128.0f) + EPS);
#pragma unroll
        for (int hh = 0; hh < 2; ++hh) { f32x4 z0, z1; unpack8(*(const u32x4*)(Z + o + 8 * hh), z0, z1); f32x4 a0, a1;
#pragma unroll
            for (int j = 0; j < 4; ++j) { a0[j] = v[8 * hh + j] * rs * siluf(z0[j]); a1[j] = v[8 * hh + 4 + j] * rs * siluf(z1[j]); }
            if (!F.dry) *(u32x4*)(OF + o + 8 * hh) = pack8(a0, a1); } }
    float* scr = (float*)(F.lds + F.wave * 17408); const float* g2 = INP(13);
    for (int it = F.gw; it < 64 * 192 + 256; it += F.ngw) { const int e = it / 192, r = it % 192;
        if (it >= 64 * 192) { const int q = it - 64 * 192, nb = q >> 4, kb = q & 15;
            tr_item64(INP(12), 1024, kb * 64, nb * 64, (bf16*)(F.ws + WS_WO), 1024, nb * 64, nb * 64 + 32, nullptr, 0, scr, F.lane, F.dry); continue; }
        if (r < 128) { const int up = r >> 6, rr = r & 63, nb = rr >> 4, kb = rr & 15, j0 = nb * 64; const int d0 = 256 * (j0 >> 7) + 128 * up + (j0 & 127);
            tr_item64((up ? INP(19) : INP(18)) + (size_t)e * 1024 * 256, 256, kb * 64, j0, (bf16*)(F.ws + WS_WGU) + (size_t)e * 512 * 1024, 1024, d0, d0 + 32, g2, 1023, scr, F.lane, F.dry); }
        else { const int rr = r - 128, nb = rr >> 2, kb = rr & 3;
            tr_item64(INP(20) + (size_t)e * 256 * 1024, 1024, kb * 64, nb * 64, (bf16*)(F.ws + WS_WDN) + (size_t)e * 1024 * 256, 256, nb * 64, nb * 64 + 32, nullptr, 0, scr, F.lane, F.dry); } }
    __syncthreads();
}

DI void phase_merge(Ctx& F) {
    bf16* MG = (bf16*)(F.ws + WS_OB); const unsigned char* GF8 = (const unsigned char*)F.out; const unsigned char* GD8 = GF8 + (size_t)NTOK * 1024 * 2;
    pg8::Gemm2 g{(const bf16*)(F.ws + WS_FM), 512, (const bf16*)(F.ws + WS_OF), 1024, (const bf16*)(F.ws + WS_WF)};
    pg8::StaticOrder S; S.init(NTOK, 1024, F.G, F.bid); EpiMerge2 E{MG, GF8, GD8};
    pg8::gemm_phase_dual((PG8_LAS unsigned char*)F.lds, g, S, E, F.wave);
}
DI void phase_outproj(Ctx& F) {
    pg8::Gemm g{(const bf16*)(F.ws + WS_OB), (const bf16*)(F.ws + WS_WO), 1024}; pg8::StaticOrder S; S.init(NTOK, 1024, F.G, F.bid); EpiOut E{INP(0), F.out};
    pg8::gemm_phase((PG8_LAS unsigned char*)F.lds, g, S, E, F.wave);
}

DI void phase_router(Ctx& F) {
    const float* H2 = F.out; const float* WR = (const float*)(F.ws + WS_WR); bf16* XN = (bf16*)(F.ws + WS_XN); int* rowtok = (int*)(F.ws + WS_ROWTOK); int* tokinfo = (int*)(F.ws + WS_TOKINFO);
    const float* brg = INP(15); const float* bre = INP(17);
    int tp = -1, pea = 0, peb = 0, ppa = 0, ppb = 0; float pw1 = 0.f, pw2 = 0.f;
    f32x4 wg[8][4];
#pragma unroll
    for (int jj = 0; jj < 8; ++jj)
#pragma unroll
        for (int j = 0; j < 4; ++j) wg[jj][j] = ((const f32x4*)(WR + (size_t)jj * 1024))[F.lane + 64 * j];
    for (int t = F.gw; t < NTOK; t += F.ngw) {
        f32x4 xv[4]; float ss = 0.f;
#pragma unroll
        for (int j = 0; j < 4; ++j) { xv[j] = ((const f32x4*)(H2 + (size_t)t * 1024))[F.lane + 64 * j]; ss += (xv[j][0] * xv[j][0] + xv[j][1] * xv[j][1]) + (xv[j][2] * xv[j][2] + xv[j][3] * xv[j][3]); }
        ss = wave_sum(ss); const float rs = __builtin_amdgcn_rsqf(ss * (1.0f / 1024.0f) + EPS);
        if (!F.dry) { u32x2* o = (u32x2*)(XN + (size_t)t * 1024);
#pragma unroll
            for (int j = 0; j < 4; ++j) { u32x2 w; w.x = pk2(xv[j][0] * rs, xv[j][1] * rs); w.y = pk2(xv[j][2] * rs, xv[j][3] * rs); o[F.lane + 64 * j] = w; } }
        float gl[8];
#pragma unroll
        for (int jj = 0; jj < 8; ++jj) { float p = 0.f;
#pragma unroll
            for (int j = 0; j < 4; ++j) { const f32x4 w = wg[jj][j]; p += (xv[j][0] * w[0] + xv[j][1] * w[1]) + (xv[j][2] * w[2] + xv[j][3] * w[3]); }
            gl[jj] = p; }
        wave_sum8(gl);
#pragma unroll
        for (int jj = 0; jj < 8; ++jj) gl[jj] = gl[jj] * rs + brg[jj];
        int gi = 0; float gm = gl[0];
#pragma unroll
        for (int jj = 1; jj < 8; ++jj) if (gl[jj] > gm) { gm = gl[jj]; gi = jj; }
        float den = 0.f;
#pragma unroll
        for (int jj = 0; jj < 8; ++jj) den += __expf(gl[jj] - gm);
        const float pg = 1.0f / den;
        gi = __builtin_amdgcn_readfirstlane(gi);
        float el[8];
#pragma unroll
        for (int jj = 0; jj < 8; ++jj) { float p = 0.f; const float* wrow = WR + (size_t)(8 + gi * 8 + jj) * 1024;
#pragma unroll
            for (int j = 0; j < 4; ++j) { const f32x4 w = ((const f32x4*)wrow)[F.lane + 64 * j]; p += (xv[j][0] * w[0] + xv[j][1] * w[1]) + (xv[j][2] * w[2] + xv[j][3] * w[3]); }
            el[jj] = p; }
        wave_sum8(el);
#pragma unroll
        for (int jj = 0; jj < 8; ++jj) el[jj] = el[jj] * rs + bre[gi * 8 + jj];
        int i1 = 0; float m1 = el[0];
#pragma unroll
        for (int jj = 1; jj < 8; ++jj) if (el[jj] > m1) { m1 = el[jj]; i1 = jj; }
        int i2 = -1; float m2 = -3.0e38f;
#pragma unroll
        for (int jj = 0; jj < 8; ++jj) if (jj != i1 && el[jj] > m2) { m2 = el[jj]; i2 = jj; }
        const float e2 = __expf(m2 - m1), w1 = pg / (1.0f + e2), w2 = pg * e2 / (1.0f + e2);
        if (F.lane == 0 && !F.dry) {
            if (tp >= 0) { rowtok[pea * MOE_CAP + ppa] = tp; rowtok[peb * MOE_CAP + ppb] = tp;
                int* ti = tokinfo + 4 * tp; ti[0] = pea * MOE_CAP + ppa; ti[1] = __builtin_bit_cast(int, pw1); ti[2] = peb * MOE_CAP + ppb; ti[3] = __builtin_bit_cast(int, pw2); }
            pea = gi * 8 + i1; peb = gi * 8 + i2; pw1 = w1; pw2 = w2; tp = t;
            ppa = (int)atomicAdd(F.ctl + CW_CNT + 64 * pea, 1u); ppb = (int)atomicAdd(F.ctl + CW_CNT + 64 * peb, 1u); }
    }
    if (F.lane == 0 && !F.dry && tp >= 0) { rowtok[pea * MOE_CAP + ppa] = tp; rowtok[peb * MOE_CAP + ppb] = tp;
        int* ti = tokinfo + 4 * tp; ti[0] = pea * MOE_CAP + ppa; ti[1] = __builtin_bit_cast(int, pw1); ti[2] = peb * MOE_CAP + ppb; ti[3] = __builtin_bit_cast(int, pw2); }
}
DI void phase_experts(Ctx& F) {
    LAS int* tab = (LAS int*)((LAS unsigned char*)F.lds + LDS_MOETAB);
    if (F.wave == 0) {
        const int e = F.lane; const int c = (int)F.ctl[CW_CNT + 64 * e]; const int nte = (c + 255) >> 8;
        const int incl = (int)incl_scan((float)nte, F.lane);
        const int run0 = incl - nte;
        for (int i = 0; i < nte; ++i) { tab[run0 + i] = e; tab[256 + run0 + i] = e * MOE_CAP + i * 256; tab[512 + run0 + i] = (c - i * 256) < 256 ? (c - i * 256) : 256; }
        if (F.lane == 63) tab[768] = incl; }
    __syncthreads();
    const int ntiles = tab[768];
    {
        pg8::Gemm g{(const bf16*)(F.ws + WS_XN), (const bf16*)(F.ws + WS_WGU), 1024};
        pg8::MoeOrder S{ntiles * 2, 2, F.G, F.vcu, tab, F.ctl + CW_READY}; EpiGU E{(bf16*)(F.ws + WS_HACT)};
        pg8::gemm_phase_gather((PG8_LAS unsigned char*)F.lds, g, (const int*)(F.ws + WS_ROWTOK), S, E, F.wave);
    }
    {
        const int G = F.G, D = ntiles * 4, n2 = 2 * ntiles > G ? 2 * ntiles - G : 0;
        const int D1 = 4 * (ntiles < G / 2 ? ntiles : G / 2), D2 = D - D1;
        int first, count;
        if (F.vcu >= n2) { const int G1 = G - n2, j = F.vcu - n2, base = D1 / G1, extra = D1 - base * G1; count = base + (j < extra ? 1 : 0); first = j * base + (j < extra ? j : extra); }
        else { const int j = F.vcu, base = D2 / n2, extra = D2 - base * n2; count = base + (j < extra ? 1 : 0); first = D1 + j * base + (j < extra ? j : extra); }
        pg8::Gemm g{(const bf16*)(F.ws + WS_HACT), (const bf16*)(F.ws + WS_WDN), 256};
        EpiDN E{F.ws, tab};
        pg8::MoeRangeOrder S{first, count, 4, tab, F.ctl + CW_READY, 16u};
        pg8::gemm_phase((PG8_LAS unsigned char*)F.lds, g, S, E, F.wave);
    }
}
DI void phase_final(Ctx& F) {
    float* H2 = F.out; const float* fg = INP(21); const int* tokinfo = (const int*)(F.ws + WS_TOKINFO);
    int* tb = (int*)(F.lds + LDS_MOETAB + 4096);
    if (F.wave == 0) { const int nte = ((int)F.ctl[CW_CNT + 64 * F.lane] + 255) >> 8; tb[F.lane] = (int)incl_scan((float)nte, F.lane) - nte; }
    __syncthreads();
    f32x4 gv[4];
#pragma unroll
    for (int j = 0; j < 4; ++j) gv[j] = ((const f32x4*)fg)[F.lane + 64 * j];
    for (int t = F.gw; t < NTOK; t += F.ngw) {
        const int i0 = tokinfo[4 * t], i1 = tokinfo[4 * t + 2]; const float w0 = __builtin_bit_cast(float, tokinfo[4 * t + 1]), w1 = __builtin_bit_cast(float, tokinfo[4 * t + 3]);
        const int h0 = tb[i0 >> 14] * 256 + (i0 & (MOE_CAP - 1)), h1 = tb[i1 >> 14] * 256 + (i1 & (MOE_CAP - 1));
        const bf16* ya = (const bf16*)(F.ws + ((h0 >> 8) < YA_SPLIT ? WS_YA_A + (size_t)h0 * 2048 : WS_YA_B + (size_t)(h0 - YA_SPLIT * 256) * 2048));
        const bf16* yb = (const bf16*)(F.ws + ((h1 >> 8) < YA_SPLIT ? WS_YA_A + (size_t)h1 * 2048 : WS_YA_B + (size_t)(h1 - YA_SPLIT * 256) * 2048));
        f32x4 v[4]; float ss = 0.f;
#pragma unroll
        for (int j = 0; j < 4; ++j) { v[j] = ((const f32x4*)(H2 + (size_t)t * 1024))[F.lane + 64 * j];
            const u32x2 a = ((const u32x2*)ya)[F.lane + 64 * j], c = ((const u32x2*)yb)[F.lane + 64 * j];
            v[j][0] += w0 * bflo(a.x) + w1 * bflo(c.x); v[j][1] += w0 * bfhi(a.x) + w1 * bfhi(c.x); v[j][2] += w0 * bflo(a.y) + w1 * bflo(c.y); v[j][3] += w0 * bfhi(a.y) + w1 * bfhi(c.y);
            ss += (v[j][0] * v[j][0] + v[j][1] * v[j][1]) + (v[j][2] * v[j][2] + v[j][3] * v[j][3]); }
        ss = wave_sum(ss); const float rs = __builtin_amdgcn_rsqf(ss * (1.0f / 1024.0f) + EPS);
        if (!F.dry) {
#pragma unroll
            for (int j = 0; j < 4; ++j) ((f32x4*)(H2 + (size_t)t * 1024))[F.lane + 64 * j] = v[j] * rs * gv[j]; }
    }
}

__global__ void __launch_bounds__(512, 2) mega_fwd(Args args) {
    extern __shared__ __attribute__((aligned(16))) unsigned char lds[];
    Ctx F;
    F.out = args.out; F.ws = args.ws; F.lds = lds; F.ctl = (unsigned*)(args.ws + WS_CTL);
    F.tid = threadIdx.x; F.lane = F.tid & 63; F.wave = __builtin_amdgcn_readfirstlane(F.tid >> 6);
    F.dry = false; F.G = gridDim.x; F.bid = blockIdx.x; F.vcu = (F.G % 8 == 0) ? (F.bid % 8) * (F.G / 8) + F.bid / 8 : F.bid; F.gw = F.vcu * 8 + F.wave; F.ngw = F.G * 8;
    const int lo = args.ph_lo, hi = args.ph_hi;
#if MK_LAUNCH_PER_PHASE
#define GRID_SYNC() do { } while (0)
#else
    volatile LAS unsigned* bst = (volatile LAS unsigned*)((LAS unsigned char*)lds + LDS_BARW);
    if (F.tid == 0) { bst[0] = 0u; bst[1] = 0u; }
    __syncthreads();
    const XcdBarrier gbar = xcd_barrier_post(F.ctl + CW_BAR, bst, F.tid == 0);
#define GRID_SYNC() xcd_barrier(gbar, F.wave == 0 && lane_id() == 0)
#endif
#ifndef MK_REPEAT
#define MK_REPEAT -1
#endif
#define REFRESH() do { F.lane = lane_id(); F.tid = F.wave * 64 + F.lane; } while (0)
#ifndef MK_DRY
#define MK_DRY -1
#endif
#if MK_DRY >= 0
    const unsigned zrt = F.ctl[CW_ZERO + 8];
#define DRYSET(v) F.dry = (v) ? (zrt == 0u) : (zrt != 0u)
#else
#define DRYSET(v) F.dry = false
#endif
#define PHASE(k, call) do { if (lo <= (k) && (k) < hi) { if ((k) == MK_REPEAT) { REFRESH(); call; GRID_SYNC(); } if ((k) == MK_DRY) { DRYSET(true); REFRESH(); call; GRID_SYNC(); } DRYSET(false); REFRESH(); call; if ((k) + 1 < hi) { GRID_SYNC(); } } } while (0)
    PHASE(0, phase_prep(F));
    PHASE(1, phase_inproj(F));
    PHASE(2, phase_dft_prep(F));
    PHASE(3, phase_scan(F));
    PHASE(4, phase_og_wexp(F));
    PHASE(5, phase_merge(F));
    PHASE(6, phase_outproj(F));
    PHASE(7, phase_router(F));
    PHASE(8, phase_experts(F));
    PHASE(9, phase_final(F));
#undef PHASE
}

extern "C" void kernel_launch(void* const* d_in, const int* in_sizes, int n_in, void* d_out, int out_size, void* d_ws, size_t ws_size, hipStream_t stream) {
    static int grid = 0;
    if (grid == 0) {
        int dev = 0, cus = 0, per_cu = 0;
        if (n_in != 22 || out_size != NTOK * DMOD || ws_size < WS_END) { fprintf(stderr, "kernel_launch: unexpected shapes (n_in %d out %d ws %zu need %zu)\n", n_in, out_size, ws_size, (size_t)WS_END); }
        hipGetDevice(&dev); hipDeviceGetAttribute(&cus, hipDeviceAttributeMultiprocessorCount, dev);
        hipFuncSetAttribute((const void*)mega_fwd, hipFuncAttributeMaxDynamicSharedMemorySize, LDS_BYTES);
        hipOccupancyMaxActiveBlocksPerMultiprocessor(&per_cu, (const void*)mega_fwd, 512, LDS_BYTES);
        if (per_cu < 1) { fprintf(stderr, "kernel_launch: occupancy query says %d blocks per CU\n", per_cu); per_cu = 1; }
        grid = cus;
        (void)hipGetLastError();
    }
    hipMemsetAsync((char*)d_ws + WS_CTL, 0, CTL_BYTES, stream);
    Args a{};
    for (int i = 0; i < 22; ++i) a.in[i] = (const float*)d_in[i];
    a.out = (float*)d_out; a.ws = (unsigned char*)d_ws;
#if MK_LAUNCH_PER_PHASE
    for (int p = 0; p < NPHASE; ++p) { a.ph_lo = p; a.ph_hi = p + 1; hipLaunchKernelGGL(mega_fwd, dim3(grid), dim3(512), LDS_BYTES, stream, a); }
#else
    a.ph_lo = 0; a.ph_hi = NPHASE;
    hipLaunchKernelGGL(mega_fwd, dim3(grid), dim3(512), LDS_BYTES, stream, a);
#endif
}
```
